# Optimizing an MI355X kernel written in HIP

```python
import math
import jax
import jax.numpy as jnp
from jax import lax
import numpy as np

D_MODEL = 1024
BATCH = 4
SEQ = 8192
DEPTH = 2

N_MEM = 256
GROUP_WIDTH = 512
D_MIX = 4 * GROUP_WIDTH
NORM_EPS = 1e-6

RET_HEADS = 4
RET_HEAD_DIM = 128
RET_CHUNK = 128
ROPE_BASE = 10000.0

SSD_HEADS = 8
SSD_HEAD_DIM = 64
SSD_GROUPS = 2
SSD_STATE = 128
SSD_CONV = 4
SSD_CHUNK = 128
SSD_BC = SSD_GROUPS * SSD_STATE
SSD_CONV_DIM = GROUP_WIDTH + 2 * SSD_BC
SSD_NORM_GROUP = GROUP_WIDTH // SSD_GROUPS
DT_MIN = 1e-3
DT_MAX = 1e-1
A_INIT_MIN = 1.0
A_INIT_MAX = 16.0

SB_HEADS = 4
SB_HEAD_DIM = 128
SB_BLOCK = 128

MEM_HEADS = 4
MEM_HEAD_DIM = 128

IN_SIZES = (GROUP_WIDTH, GROUP_WIDTH, GROUP_WIDTH, GROUP_WIDTH,
            SSD_CONV_DIM, GROUP_WIDTH, SSD_HEADS,
            GROUP_WIDTH, GROUP_WIDTH, GROUP_WIDTH, GROUP_WIDTH,
            GROUP_WIDTH, GROUP_WIDTH)
D_IN = sum(IN_SIZES)

kernel_name = 'hymba_style_ret_ssd_stickbreak_mem'


def rmsnorm(x, g):
    xf = x.astype(jnp.float32)
    y = xf * lax.rsqrt(jnp.mean(xf * xf, axis=-1, keepdims=True) + NORM_EPS)
    return (y * g.astype(jnp.float32)).astype(x.dtype)


def apply_rope(t):
    s, d = t.shape[1], t.shape[-1]
    inv_freq = ROPE_BASE ** (-jnp.arange(0, d, 2, dtype=jnp.float32) / d)
    ang = jnp.arange(s, dtype=jnp.float32)[:, None] * inv_freq[None, :]
    cos = jnp.cos(ang)[None, :, None, :]
    sin = jnp.sin(ang)[None, :, None, :]
    t1, t2 = jnp.split(t.astype(jnp.float32), 2, axis=-1)
    return jnp.concatenate([t1 * cos - t2 * sin, t2 * cos + t1 * sin], axis=-1).astype(t.dtype)


def retention(q, k, v):
    b, s, h, d = q.shape
    dv = v.shape[-1]
    c = RET_CHUNK
    nc = s // c
    dt = v.dtype
    q = apply_rope(q)
    k = apply_rope(k) * (d ** -0.5)
    log_g = jnp.log(1.0 - 2.0 ** (-5.0 - jnp.arange(h, dtype=jnp.float32)))
    idx = jnp.arange(c, dtype=jnp.float32)
    rel = idx[:, None] - idx[None, :]
    intra = jnp.where(rel[None] >= 0, jnp.exp(rel[None] * log_g[:, None, None]), 0.0)
    zeta = jnp.exp((c - 1 - idx)[:, None] * log_g[None, :])
    xi = jnp.exp((idx + 1)[:, None] * log_g[None, :])
    chunk_decay = jnp.exp(c * log_g)
    qc = q.reshape(b, nc, c, h, d)
    kc = k.reshape(b, nc, c, h, d)
    vc = v.reshape(b, nc, c, h, dv)
    scores = jnp.einsum('bcnhd,bcmhd->bchnm', qc, kc) * intra.astype(dt)
    y_intra = jnp.einsum('bchnm,bcmhe->bcnhe', scores, vc)
    kv = jnp.einsum('bcmhd,bcmhe->bchde', kc * zeta.astype(dt)[:, :, None], vc)

    def step(state, kv_c):
        return chunk_decay[:, None, None] * state + kv_c, state

    _, r_prev = lax.scan(step, jnp.zeros((b, h, d, dv), jnp.float32),
                         jnp.moveaxis(kv.astype(jnp.float32), 1, 0))
    r_prev = jnp.moveaxis(r_prev, 0, 1).astype(dt)
    y_inter = jnp.einsum('bcnhd,bchde->bcnhe', qc, r_prev) * xi.astype(dt)[:, :, None]
    y = (y_intra + y_inter).reshape(b, s, h, dv).astype(jnp.float32)
    mu = jnp.mean(y, axis=-1, keepdims=True)
    var = jnp.mean(jnp.square(y - mu), axis=-1, keepdims=True)
    y = (y - mu) * lax.rsqrt(var + NORM_EPS)
    return y.reshape(b, s, h * dv).astype(dt)


def ssd_mixer(xbc, z, dt_raw, conv_w, conv_b, dt_bias, a_log, d_skip, norm_g):
    b, s, _ = xbc.shape
    dtype = xbc.dtype
    L = SSD_CHUNK
    nc = s // L
    G, J, P, N = SSD_GROUPS, SSD_HEADS // SSD_GROUPS, SSD_HEAD_DIM, SSD_STATE
    xbc = lax.conv_general_dilated(xbc, conv_w[:, None, :], window_strides=(1,),
                                   padding=[(SSD_CONV - 1, 0)],
                                   dimension_numbers=('NWC', 'WIO', 'NWC'),
                                   feature_group_count=SSD_CONV_DIM)
    xbc = jax.nn.silu(xbc + conv_b)
    xs, bm, cm = jnp.split(xbc, [GROUP_WIDTH, GROUP_WIDTH + SSD_BC], axis=-1)
    delta = jax.nn.softplus(dt_raw.astype(jnp.float32) + dt_bias.astype(jnp.float32))
    da = (delta * -jnp.exp(a_log.astype(jnp.float32))).reshape(b, nc, L, SSD_HEADS)
    x_heads = xs.reshape(b, s, SSD_HEADS, P)
    xdt = (x_heads * delta[..., None].astype(dtype)).reshape(b, nc, L, G, J, P)
    bc = bm.reshape(b, nc, L, G, N)
    cc = cm.reshape(b, nc, L, G, N)
    a_cs = jnp.cumsum(da, axis=2)
    causal = jnp.tril(jnp.ones((L, L), dtype=bool))[None, None, :, :, None]
    seg = a_cs[:, :, :, None, :] - a_cs[:, :, None, :, :]
    decay_in = jnp.exp(jnp.where(causal, seg, -jnp.inf)).reshape(b, nc, L, L, G, J)
    cb = jnp.einsum('bclgn,bcsgn->bclsg', cc, bc)
    y_diag = jnp.einsum('bclsgj,bcsgjp->bclgjp', cb[..., None] * decay_in.astype(dtype), xdt)
    decay_states = jnp.exp(a_cs[:, :, -1:, :] - a_cs).reshape(b, nc, L, G, J)
    states = jnp.einsum('bclgn,bclgjp->bcgjpn', bc, xdt * decay_states.astype(dtype)[..., None])
    chunk_decay = jnp.exp(a_cs[:, :, -1, :]).reshape(b, nc, G, J)

    def step(state, inp):
        dec, st = inp
        return dec[..., None, None] * state + st, state

    _, prev = lax.scan(step, jnp.zeros((b, G, J, P, N), jnp.float32),
                       (jnp.moveaxis(chunk_decay, 1, 0), jnp.moveaxis(states.astype(jnp.float32), 1, 0)))
    prev = jnp.moveaxis(prev, 0, 1).astype(dtype)
    y_off = jnp.einsum('bclgn,bcgjpn->bclgjp', cc, prev) * jnp.exp(a_cs).reshape(b, nc, L, G, J, 1).astype(dtype)
    y = (y_diag + y_off).reshape(b, s, SSD_HEADS, P) + x_heads * d_skip.astype(dtype)[:, None]
    y = y.reshape(b, s, GROUP_WIDTH) * jax.nn.silu(z)
    y = rmsnorm(y.reshape(b, s, SSD_GROUPS, SSD_NORM_GROUP), norm_g.reshape(SSD_GROUPS, SSD_NORM_GROUP))
    return y.reshape(b, s, GROUP_WIDTH)


def stick_breaking(q, k, v):
    b, s, h, d = q.shape
    nb = s // SB_BLOCK
    scale = d ** -0.5
    key_pos = jnp.arange(s)
    qb = jnp.moveaxis(q.reshape(b, nb, SB_BLOCK, h, d), 1, 0)

    def block(args):
        q_blk, i = args
        logits = jnp.einsum('bthd,bshd->bhts', q_blk, k).astype(jnp.float32) * scale
        q_pos = i * SB_BLOCK + jnp.arange(SB_BLOCK)
        causal = key_pos[None, :] < q_pos[:, None]
        log_beta = jax.nn.log_sigmoid(logits)
        log_1mb = jnp.where(causal, jax.nn.log_sigmoid(-logits), 0.0)
        tail = lax.cumsum(log_1mb, axis=3, reverse=True) - log_1mb
        w = jnp.where(causal, jnp.exp(log_beta + tail), 0.0)
        return jnp.einsum('bhts,bshd->bthd', w.astype(v.dtype), v)

    out = lax.map(block, (qb, jnp.arange(nb)))
    return jnp.moveaxis(out, 0, 1).reshape(b, s, h * d)


def memory_read(q, mem_n, w_mem_kv):
    b, s, h, d = q.shape
    kv = mem_n @ w_mem_kv
    k, v = jnp.split(kv, 2, axis=-1)
    k = k.reshape(b, -1, h, d)
    v = v.reshape(b, -1, h, d)
    logits = jnp.einsum('bshd,bmhd->bhsm', q, k).astype(jnp.float32) * (d ** -0.5)
    p = jax.nn.softmax(logits, axis=-1).astype(v.dtype)
    return jnp.einsum('bhsm,bmhd->bshd', p, v).reshape(b, s, h * d)


def hybrid_layer(x, mem, pre_g, post_g, w_in, conv_w, conv_b, dt_bias, a_log, d_skip,
                 ssd_norm_g, mem_norm_g, w_mem_kv, w_out):
    b, s, _ = x.shape
    hn = rmsnorm(x, pre_g)
    proj = hn @ w_in
    (ret_q, ret_k, ret_v, ret_g, xbc, z, dt_raw,
     sb_q, sb_k, sb_v, sb_g, mem_q, mem_g) = jnp.split(proj, list(np.cumsum(IN_SIZES)[:-1]), axis=-1)
    y_ret = retention(ret_q.reshape(b, s, RET_HEADS, RET_HEAD_DIM),
                      ret_k.reshape(b, s, RET_HEADS, RET_HEAD_DIM),
                      ret_v.reshape(b, s, RET_HEADS, RET_HEAD_DIM)) * jax.nn.silu(ret_g)
    y_ssd = ssd_mixer(xbc, z, dt_raw, conv_w, conv_b, dt_bias, a_log, d_skip, ssd_norm_g)
    y_sb = stick_breaking(sb_q.reshape(b, s, SB_HEADS, SB_HEAD_DIM),
                          sb_k.reshape(b, s, SB_HEADS, SB_HEAD_DIM),
                          sb_v.reshape(b, s, SB_HEADS, SB_HEAD_DIM)) * jax.nn.silu(sb_g)
    y_mem = memory_read(mem_q.reshape(b, s, MEM_HEADS, MEM_HEAD_DIM),
                        rmsnorm(mem, mem_norm_g), w_mem_kv) * jax.nn.silu(mem_g)
    y = jnp.concatenate([y_ret, y_ssd, y_sb, y_mem], axis=-1) @ w_out
    return x + rmsnorm(y, post_g)


def setup_inputs(seed: int = 0) -> dict:
    key = jax.random.key(seed)
    ks = jax.random.split(key, 14)
    f32 = jnp.float32

    def gain(k, shape):
        return 1.0 + 0.02 * jax.random.normal(k, shape, f32)

    dt0 = jnp.exp(jax.random.uniform(ks[7], (DEPTH, SSD_HEADS), f32, math.log(DT_MIN), math.log(DT_MAX)))
    return {
        'x': jax.random.normal(ks[0], (BATCH, SEQ, D_MODEL), f32),
        'mem': jax.random.normal(ks[1], (BATCH, N_MEM, D_MODEL), f32),
        'pre_norm_g': gain(ks[2], (DEPTH, D_MODEL)),
        'post_norm_g': gain(ks[3], (DEPTH, D_MODEL)),
        'w_in': jax.random.normal(ks[4], (DEPTH, D_MODEL, D_IN), f32) * D_MODEL ** -0.5,
        'conv_w': jax.random.normal(ks[5], (DEPTH, SSD_CONV, SSD_CONV_DIM), f32) * SSD_CONV ** -0.5,
        'conv_b': 0.02 * jax.random.normal(ks[6], (DEPTH, SSD_CONV_DIM), f32),
        'dt_bias': dt0 + jnp.log(-jnp.expm1(-dt0)),
        'a_log': jnp.log(jax.random.uniform(ks[8], (DEPTH, SSD_HEADS), f32, A_INIT_MIN, A_INIT_MAX)),
        'd_skip': gain(ks[9], (DEPTH, SSD_HEADS)),
        'ssd_norm_g': gain(ks[10], (DEPTH, GROUP_WIDTH)),
        'mem_norm_g': gain(ks[11], (DEPTH, D_MODEL)),
        'w_mem_kv': jax.random.normal(ks[12], (DEPTH, D_MODEL, 2 * GROUP_WIDTH), f32) * D_MODEL ** -0.5,
        'w_out': jax.random.normal(ks[13], (DEPTH, D_MIX, D_MODEL), f32) * D_MIX ** -0.5,
    }


def reference(x, mem, pre_norm_g, post_norm_g, w_in, conv_w, conv_b, dt_bias, a_log, d_skip,
              ssd_norm_g, mem_norm_g, w_mem_kv, w_out):
    for l in range(DEPTH):
        x = hybrid_layer(x, mem, pre_norm_g[l], post_norm_g[l], w_in[l], conv_w[l], conv_b[l],
                         dt_bias[l], a_log[l], d_skip[l], ssd_norm_g[l], mem_norm_g[l],
                         w_mem_kv[l], w_out[l])
    return x
```

```cpp
#include <hip/hip_runtime.h>
#include <hip/hip_cooperative_groups.h>
#include <cstdio>
namespace cg = cooperative_groups;

#define LAS __attribute__((address_space(3)))
typedef unsigned short u16;
typedef short bf16x8 __attribute__((ext_vector_type(8)));
typedef short s16x4 __attribute__((ext_vector_type(4)));
typedef float f32x4 __attribute__((ext_vector_type(4)));
typedef unsigned u32x4 __attribute__((ext_vector_type(4)));
typedef unsigned u32x2 __attribute__((ext_vector_type(2)));
typedef LAS unsigned char* lds_t;

#ifndef N_LAUNCH_MODE
#define N_LAUNCH_MODE 1
#endif

constexpr int T_TOK = 32768, SEQ = 8192, DM = 1024, NP = 6656, DIN = 6664, NCHUNK = 64;
constexpr int C_RQ = 0, C_RK = 512, C_RV = 1024, C_XBC = 1536, C_SQ = 2560, C_SK = 3072, C_SV = 3584, C_MQ = 4096,
              C_RG = 4608, C_Z = 5120, C_SG = 5632, C_MG = 6144;
constexpr float EPS = 1e-6f;
constexpr int NTHR = 512;
#ifndef PM
#define PM 1023
#endif
constexpr int LDS_BYTES = 151552;

constexpr size_t WS_PROJ = 0;
constexpr size_t WS_ST = 436207616ull;
constexpr size_t WS_WIN = WS_ST + 67108864ull;
constexpr size_t WS_WOUT = WS_WIN + 13631488ull;
constexpr size_t WS_MEMKV = WS_WOUT + 4194304ull;
constexpr size_t WS_ROPE = WS_MEMKV + 4194304ull;
constexpr size_t WS_DT = WS_ROPE + 4194304ull;
constexpr size_t WS_CDEC = WS_DT + 1048576ull;
constexpr size_t WS_BAR = WS_CDEC + 8192ull;
constexpr size_t WS_END = WS_BAR + 16384ull;

constexpr size_t STRM = (size_t)T_TOK * 32;
__device__ __forceinline__ unsigned short* PJ(unsigned short* proj, size_t tok, int col) { return proj + (size_t)(col >> 5) * STRM + tok * 32 + (col & 31); }
__device__ __forceinline__ const unsigned short* PJ(const unsigned short* proj, size_t tok, int col) { return proj + (size_t)(col >> 5) * STRM + tok * 32 + (col & 31); }

struct Params {
    const float* x; const float* mem; const float* pre_g; const float* post_g; const float* w_in; const float* conv_w; const float* conv_b;
    const float* dt_bias; const float* a_log; const float* d_skip; const float* ssd_norm_g; const float* mem_norm_g; const float* w_mem_kv; const float* w_out;
    float* out; unsigned char* ws; int ph_lo, ph_hi; unsigned char prog[32]; int dmask, pad_;
};

typedef __bf16 bf16x2_t __attribute__((ext_vector_type(2)));
typedef float f32x2_t __attribute__((ext_vector_type(2)));
__device__ __forceinline__ unsigned pk2(float lo, float hi) { const f32x2_t v = {lo, hi}; const bf16x2_t b = __builtin_convertvector(v, bf16x2_t); return __builtin_bit_cast(unsigned, b); }
__device__ __forceinline__ u16 f2bf(float f) { return (u16)(pk2(f, 0.f) & 0xffffu); }
__device__ __forceinline__ float bf2f(u16 b) { return __uint_as_float(((unsigned)b) << 16); }
__device__ __forceinline__ float bflo(unsigned w) { return __uint_as_float(w << 16); }
__device__ __forceinline__ float bfhi(unsigned w) { return __uint_as_float(w & 0xffff0000u); }
__device__ __forceinline__ float siluf(float v) { return v / (1.f + __expf(-v)); }
__device__ __forceinline__ float softplusf(float x) { return fmaxf(x, 0.f) + log1pf(__expf(-fabsf(x))); }
__device__ __forceinline__ int otid() { int t = __builtin_amdgcn_workitem_id_x(); asm volatile("" : "+v"(t)); return t; }
#define MFMA16(a, b, c) __builtin_amdgcn_mfma_f32_16x16x32_bf16(a, b, c, 0, 0, 0)

__device__ __forceinline__ bf16x8 frag_row(lds_t base, int ld, int i0, int k0, int fr, int fq) {
    return *(const LAS bf16x8*)(base + ((i0 + fr) * ld + k0 + fq * 8) * 2);
}
__device__ __forceinline__ s16x4 trrd(lds_t p) { return __builtin_bit_cast(s16x4, __builtin_amdgcn_ds_read_tr16_b64_v4i16((LAS s16x4*)p)); }
__device__ __forceinline__ bf16x8 frag_tr(lds_t base, int ld, int i0, int k0, int fr, int fq) {
    lds_t p = base + ((k0 + 8 * fq + (fr >> 2)) * ld + i0 + 4 * (fr & 3)) * 2;
    const s16x4 lo = trrd(p), hi = trrd(p + 8 * ld);
    return (bf16x8){lo[0], lo[1], lo[2], lo[3], hi[0], hi[1], hi[2], hi[3]};
}
__device__ __forceinline__ void copy_tile(lds_t dst, int ldd, const u16* src, size_t lds_, int rows, int cpr_shift) {
    const int n = rows << cpr_shift;
#pragma unroll
    for (int i = otid(); i < n; i += NTHR) { const int r = i >> cpr_shift, ch = i & ((1 << cpr_shift) - 1);
        const u32x4 v = *(const u32x4*)(src + (size_t)r * lds_ + ch * 8);
        *(LAS u32x4*)(dst + (r * ldd + ch * 8) * 2) = v; }
}
__device__ __forceinline__ void copy_tile_pj(lds_t dst, int ldd, const unsigned short* proj, size_t tok0, int col) {
#pragma unroll
    for (int i = otid(); i < 2048; i += NTHR) { const int r = (i >> 2) & 127, ch = ((i >> 9) << 2) | (i & 3);
        const u32x4 v = *(const u32x4*)PJ(proj, tok0 + r, col + ch * 8);
        *(LAS u32x4*)(dst + (r * ldd + ch * 8) * 2) = v; }
}
__device__ __forceinline__ void rope_tile(lds_t dst, const u16* proj, size_t tok0, int col, const float* rc, const float* rs, int pos0, float bscale, float zl2) {
#pragma unroll
    for (int i = otid(); i < 1024; i += NTHR) { const int m = (i >> 2) & 127, ch = ((i >> 9) << 2) | (i & 3);
        const u32x4 a = *(const u32x4*)PJ(proj, tok0 + m, col + ch * 8), b = *(const u32x4*)PJ(proj, tok0 + m, col + 64 + ch * 8);
        const float* cp = rc + (size_t)(pos0 + m) * 64 + ch * 8; const float* sp = rs + (size_t)(pos0 + m) * 64 + ch * 8;
        const f32x4 c0 = *(const f32x4*)cp, c1 = *(const f32x4*)(cp + 4), s0 = *(const f32x4*)sp, s1 = *(const f32x4*)(sp + 4);
        const float sc = bscale * exp2f(zl2 * (float)(127 - m));
        float t1[8], t2[8], cc[8], ss[8], o1[8], o2[8];
#pragma unroll
        for (int e = 0; e < 4; ++e) { t1[2 * e] = bflo(a[e]); t1[2 * e + 1] = bfhi(a[e]); t2[2 * e] = bflo(b[e]); t2[2 * e + 1] = bfhi(b[e]);
            cc[e] = c0[e]; cc[e + 4] = c1[e]; ss[e] = s0[e]; ss[e + 4] = s1[e]; }
#pragma unroll
        for (int e = 0; e < 8; ++e) { o1[e] = (t1[e] * cc[e] - t2[e] * ss[e]) * sc; o2[e] = (t2[e] * cc[e] + t1[e] * ss[e]) * sc; }
        u32x4 w1, w2;
#pragma unroll
        for (int e = 0; e < 4; ++e) { w1[e] = pk2(o1[2 * e], o1[2 * e + 1]); w2[e] = pk2(o2[2 * e], o2[2 * e + 1]); }
        *(LAS u32x4*)(dst + (m * 136 + ch * 8) * 2) = w1; *(LAS u32x4*)(dst + (m * 136 + 64 + ch * 8) * 2) = w2; }
}
template <int NCH, bool SCALE>
__device__ __forceinline__ void conv_tile(lds_t dst, int ldd, const u16* proj, size_t tok0, int pos0, int ch0, const float* cw, const float* cb, lds_t scl) {
    constexpr int TPC = NTHR / NCH, RPT = 128 / TPC;
    const int t = otid(), chunk = t % NCH, rs0 = (t / NCH) * RPT, ch = ch0 + chunk * 8;
    float w[4][8], bias[8];
#pragma unroll
    for (int j = 0; j < 4; ++j) { const f32x4 a = *(const f32x4*)(cw + j * 1024 + ch), b = *(const f32x4*)(cw + j * 1024 + ch + 4);
#pragma unroll
        for (int e = 0; e < 4; ++e) { w[j][e] = a[e]; w[j][e + 4] = b[e]; } }
    { const f32x4 a = *(const f32x4*)(cb + ch), b = *(const f32x4*)(cb + ch + 4);
#pragma unroll
      for (int e = 0; e < 4; ++e) { bias[e] = a[e]; bias[e + 4] = b[e]; } }
    u32x4 x[RPT + 3];
#pragma unroll
    for (int i = 0; i < RPT + 3; ++i) { const int rr = rs0 - 3 + i; x[i] = (u32x4){0u, 0u, 0u, 0u};
        if (pos0 + rr >= 0) x[i] = *(const u32x4*)PJ(proj, tok0 + rr, C_XBC + ch); }
#pragma unroll
    for (int i = 0; i < RPT; ++i) { const int r = rs0 + i;
        float acc[8];
#pragma unroll
        for (int e = 0; e < 8; ++e) acc[e] = bias[e];
#pragma unroll
        for (int j = 0; j < 4; ++j) { const u32x4 v = x[i + j];
#pragma unroll
            for (int e = 0; e < 4; ++e) { acc[2 * e] += w[j][2 * e] * bflo(v[e]); acc[2 * e + 1] += w[j][2 * e + 1] * bfhi(v[e]); } }
        float sc = 1.f;
        if (SCALE) sc = *(const LAS float*)(scl + (r * 4 + (chunk >> 3)) * 4);
        u32x4 o;
#pragma unroll
        for (int e = 0; e < 4; ++e) o[e] = pk2(siluf(acc[2 * e]) * sc, siluf(acc[2 * e + 1]) * sc);
        *(LAS u32x4*)(dst + (r * ldd + chunk * 8) * 2) = o;
    }
}

namespace pg8 {
constexpr int BM = 256, BK = 64, HALF = 128, HTB = HALF * BK * 2, STAGE_BYTES = 8 * HTB, NXCD = 8, WGM = 8;
__device__ __forceinline__ int lds_byte(int r, int c) { const int st = (r >> 4) * 2 + (c >> 5), rr = r & 15, cc = c & 31, ob = rr * 64 + cc * 2; return st * 1024 + (ob ^ (((ob >> 9) & 1) << 5)); }
__device__ __forceinline__ void stage_rc(int b, int& R, int& C) { const int st = b / 1024, sb = b % 1024, swz = sb ^ (((sb >> 9) & 1) << 5); R = (st >> 1) * 16 + swz / 64; C = (st & 1) * 32 + (swz % 64) / 2; }
__device__ __forceinline__ int perm32(int rho) { const int n = rho >> 4, i = rho & 15; return 8 * (i >> 2) + 4 * n + (i & 3); }
struct Unit { int pm, pn; };
struct Gemm { const u16* A; const u16* Bt; int M, N, K, lda, ldb; u16* O; int ldc; int astream, ostream; };
struct StaticOrder {
    int nM, nN, nwg, G, c;
    __device__ void init(int M, int N, int G_, int c_) { nM = M / BM; nN = N / BM; nwg = nM * nN; G = G_; c = c_; }
    __device__ bool next(int i, Unit& u) const {
        const long L = (long)i * G + c; if (L >= nwg) return false;
        int wgid = (int)L; { const int q = nwg / NXCD, r = nwg % NXCD, xcd = wgid % NXCD, off = wgid / NXCD; wgid = (xcd < r ? xcd * (q + 1) : r * (q + 1) + (xcd - r) * q) + off; }
        const int nig = WGM * nN, gid = wgid / nig, fm = gid * WGM, gsz = (nM - fm) < WGM ? (nM - fm) : WGM;
        u.pm = fm + ((wgid % nig) % gsz); u.pn = (wgid % nig) / gsz; return true;
    }
};
__device__ __forceinline__ void epi_bf16(const Gemm& g, const f32x4 (&acc)[2][2][4][2], const Unit& u, int wr, int wc, int fr, int fq) {
    const int row0 = u.pm * BM + wr * 64 + fr, col0 = u.pn * BM + wc * 32 + 8 * fq;
#pragma unroll
    for (int ai = 0; ai < 2; ++ai)
#pragma unroll
        for (int m = 0; m < 4; ++m) { const size_t row = (size_t)(row0 + ai * HALF + m * 16);
            u16* rowp = g.ostream ? g.O + (size_t)(8 * u.pn + wc) * STRM + row * 32 + 8 * fq : g.O + row * g.ldc + col0;
            const size_t bstep = g.ostream ? 4 * STRM : (size_t)HALF;
#pragma unroll
            for (int bj = 0; bj < 2; ++bj) { const f32x4 v0 = acc[ai][bj][m][0], v1 = acc[ai][bj][m][1];
                u32x4 w; w.x = pk2(v0[0], v0[1]); w.y = pk2(v0[2], v0[3]); w.z = pk2(v1[0], v1[1]); w.w = pk2(v1[2], v1[3]);
                *(u32x4*)(rowp + bj * bstep) = w; } }
}
__device__ __forceinline__ void gemm_phase(lds_t lds, const Gemm g, const StaticOrder& S) {
    const int tid = otid(), wid = __builtin_amdgcn_readfirstlane(tid >> 6), lane = tid & 63, wr = wid >> 2, wc = wid & 3, fr = lane & 15, fq = lane >> 4;
    const int K = g.K, nt = K / BK;
    unsigned voffA[2], voffB[2];
#pragma unroll
    for (int i = 0; i < 2; ++i) { int R, C; stage_rc(tid * 16 + i * 8192, R, C); const int Rb = (R & ~31) + perm32(R & 31);
        voffA[i] = g.astream ? (unsigned)((size_t)(C >> 5) * STRM + R * 32 + (C & 31)) * 2u : (unsigned)(R * g.lda + C) * 2u; voffB[i] = (unsigned)(Rb * g.ldb + C) * 2u; }
    const size_t kstep = (size_t)(BK * 2);
    const bool astr = g.astream != 0;
#define PG8_KOFFA(t) (astr ? (size_t)(t) * (STRM * 4) : (size_t)(t) * 128)
    const size_t hstepA = (size_t)HALF * g.lda * 2, hstepB = (size_t)HALF * g.ldb * 2;
    const size_t tstepA = 2 * hstepA, tstepB = 2 * hstepB;
    const unsigned ldsw = (unsigned)wid * 1024u;
    const int aoff = lds_byte(wr * 64 + fr, fq * 8), boff = lds_byte(wc * 32 + fr, fq * 8);
#define PG8_SA(b, h) (((b) * 2 + (h)) * HTB)
#define PG8_SB(b, h) ((4 + (b) * 2 + (h)) * HTB)
#define PG8_STAGE(bufoff, gbase, voff) do { _Pragma("unroll") for (int _i = 0; _i < 2; ++_i) \
        __builtin_amdgcn_global_load_lds((const unsigned*)((const char*)(gbase) + (voff)[_i]), (LAS unsigned*)(lds + (bufoff) + ldsw + _i * 8192), 16, 0, 0); } while (0)
#define PG8_LDA(dst, b, h) do { _Pragma("unroll") for (int m = 0; m < 4; ++m) _Pragma("unroll") for (int k = 0; k < 2; ++k) dst[m][k] = *(const LAS bf16x8*)(lds + PG8_SA(b, h) + aoff + m * 2048 + k * 1024); } while (0)
#define PG8_LDB(dst, b, h) do { _Pragma("unroll") for (int n = 0; n < 2; ++n) _Pragma("unroll") for (int k = 0; k < 2; ++k) dst[n][k] = *(const LAS bf16x8*)(lds + PG8_SB(b, h) + boff + n * 2048 + k * 1024); } while (0)
#define PG8_MMA(ai, bj, At, Bt) do { __builtin_amdgcn_s_setprio(1); _Pragma("unroll") for (int m = 0; m < 4; ++m) _Pragma("unroll") for (int n = 0; n < 2; ++n) _Pragma("unroll") for (int k = 0; k < 2; ++k) \
        acc[ai][bj][m][n] = __builtin_amdgcn_mfma_f32_16x16x32_bf16(Bt[n][k], At[m][k], acc[ai][bj][m][n], 0, 0, 0); __builtin_amdgcn_s_setprio(0); } while (0)
#define PG8_WAIT_V(n) asm volatile("s_waitcnt vmcnt(" #n ")" ::: "memory")
#define PG8_WAIT_L(n) asm volatile("s_waitcnt lgkmcnt(" #n ")" ::: "memory")
#define PG8_BAR __builtin_amdgcn_s_barrier()
#define PG8_SCHED __builtin_amdgcn_sched_barrier(0)
    Unit cur, nxt; int ui = 0;
    if (!S.next(0, cur)) return;
    f32x4 acc[2][2][4][2];
#pragma unroll
    for (int a = 0; a < 2; ++a)
#pragma unroll
        for (int b = 0; b < 2; ++b)
#pragma unroll
            for (int m = 0; m < 4; ++m)
#pragma unroll
                for (int n = 0; n < 2; ++n) acc[a][b][m][n] = (f32x4){0.f, 0.f, 0.f, 0.f};
    bf16x8 At[4][2], B0[2][2], B1[2][2];
    const char* cA = (const char*)g.A + (size_t)cur.pm * tstepA; const char* cB = (const char*)g.Bt + (size_t)cur.pn * tstepB;
    PG8_STAGE(PG8_SB(0, 0), cB, voffB); PG8_STAGE(PG8_SA(0, 0), cA, voffA); PG8_STAGE(PG8_SB(0, 1), cB + hstepB, voffB); PG8_STAGE(PG8_SA(0, 1), cA + hstepA, voffA);
    if (wr == 1) PG8_BAR;
    PG8_WAIT_V(4); PG8_BAR;
    PG8_STAGE(PG8_SB(1, 0), cB + kstep, voffB); PG8_STAGE(PG8_SA(1, 0), cA + PG8_KOFFA(1), voffA); PG8_STAGE(PG8_SB(1, 1), cB + hstepB + kstep, voffB);
    PG8_WAIT_V(6); PG8_BAR;
    for (;;) {
        const bool has_next = S.next(ui + 1, nxt);
        const char* nA = has_next ? (const char*)g.A + (size_t)nxt.pm * tstepA : cA; const char* nB = has_next ? (const char*)g.Bt + (size_t)nxt.pn * tstepB : cB;
        for (int t = 0; t < nt; t += 2) {
            const bool last = (t == nt - 2);
            const char* a1 = cA + PG8_KOFFA(t + 1);
            const char* a2 = last ? nA : cA + PG8_KOFFA(t + 2); const char* b2 = last ? nB : cB + (size_t)(t + 2) * kstep;
            const char* a3 = last ? nA + PG8_KOFFA(1) : cA + PG8_KOFFA(t + 3); const char* b3 = b2 + kstep;
            PG8_LDB(B0, 0, 0); PG8_SCHED; PG8_LDA(At, 0, 0); PG8_STAGE(PG8_SA(1, 1), a1 + hstepA, voffA);
            PG8_WAIT_L(8); PG8_BAR; PG8_WAIT_L(0); PG8_MMA(0, 0, At, B0); PG8_BAR; PG8_SCHED;
            PG8_LDB(B1, 0, 1); PG8_STAGE(PG8_SB(0, 0), b2, voffB);
            PG8_BAR; PG8_WAIT_L(0); PG8_MMA(0, 1, At, B1); PG8_BAR;
            PG8_LDA(At, 0, 1); PG8_STAGE(PG8_SA(0, 0), a2, voffA);
            PG8_BAR; PG8_WAIT_L(0); PG8_MMA(1, 0, At, B0); PG8_BAR; PG8_SCHED;
            PG8_STAGE(PG8_SB(0, 1), b2 + hstepB, voffB);
            PG8_WAIT_V(6); PG8_BAR; PG8_MMA(1, 1, At, B1); PG8_BAR;
            PG8_LDB(B0, 1, 0); PG8_SCHED; PG8_LDA(At, 1, 0); PG8_STAGE(PG8_SA(0, 1), a2 + hstepA, voffA);
            PG8_WAIT_L(8); PG8_BAR; PG8_WAIT_L(0); PG8_MMA(0, 0, At, B0); PG8_BAR; PG8_SCHED;
            PG8_LDB(B1, 1, 1); PG8_STAGE(PG8_SB(1, 0), b3, voffB);
            PG8_BAR; PG8_WAIT_L(0); PG8_MMA(0, 1, At, B1); PG8_BAR;
            PG8_LDA(At, 1, 1); PG8_STAGE(PG8_SA(1, 0), a3, voffA);
            PG8_BAR; PG8_WAIT_L(0); PG8_MMA(1, 0, At, B0); PG8_BAR; PG8_SCHED;
            PG8_STAGE(PG8_SB(1, 1), b3 + hstepB, voffB);
            PG8_WAIT_V(6); PG8_BAR; PG8_MMA(1, 1, At, B1); PG8_BAR;
        }
        epi_bf16(g, acc, cur, wr, wc, fr, fq);
        if (!has_next) break;
#pragma unroll
        for (int a = 0; a < 2; ++a)
#pragma unroll
            for (int b = 0; b < 2; ++b)
#pragma unroll
                for (int m = 0; m < 4; ++m)
#pragma unroll
                    for (int n = 0; n < 2; ++n) acc[a][b][m][n] = (f32x4){0.f, 0.f, 0.f, 0.f};
        cur = nxt; cA = nA; cB = nB; ++ui;
    }
    PG8_WAIT_V(0);
    if (wr == 0) PG8_BAR;
    PG8_BAR;
#undef PG8_KOFFA
#undef PG8_SA
#undef PG8_SB
#undef PG8_STAGE
#undef PG8_LDA
#undef PG8_LDB
#undef PG8_MMA
#undef PG8_WAIT_V
#undef PG8_WAIT_L
#undef PG8_BAR
#undef PG8_SCHED
}
}

__device__ __forceinline__ int win_srccol(int seg) {
    switch (seg) { case 0: return 0; case 1: return 512; case 2: return 1024; case 3: return 2048; case 4: return 2560; case 5: return 3592; case 6: return 4104;
                   case 7: return 4616; case 8: return 5640; case 9: return 1536; case 10: return 3072; case 11: return 5128; default: return 6152; }
}
__device__ __forceinline__ void wt_tile(lds_t lds, const float* src, int src_ld, int scol0, u16* dst, int K, int k0, int n0) {
    const int c = otid() & 63, r8 = otid() >> 6;
#pragma unroll
    for (int i = 0; i < 8; ++i) { const int r = r8 + 8 * i; *(LAS float*)(lds + (r * 65 + c) * 4) = src[(size_t)(k0 + r) * src_ld + scol0 + c]; }
    __syncthreads();
#pragma unroll
    for (int i = 0; i < 8; ++i) { const int nn = r8 + 8 * i; dst[(size_t)(n0 + nn) * K + k0 + c] = f2bf(*(const LAS float*)(lds + (c * 65 + nn) * 4)); }
    __syncthreads();
}
template <bool WIN>
__device__ __forceinline__ void convert_mat(lds_t lds, const float* src, int src_ld, u16* dst, int K, int kshift  , int nunits) {
    const int c = otid() & 63, r8 = otid() >> 6, G = gridDim.x;
    for (int u0 = blockIdx.x; u0 < nunits; u0 += 4 * G) {
        float v[4][8];
#pragma unroll
        for (int q = 0; q < 4; ++q) { const int u = u0 + q * G; const bool ok = u < nunits; const int uu = ok ? u : u0;
            const int kt = uu & ((1 << kshift) - 1), n0 = (uu >> kshift) * 64, k0 = kt * 64;
            const int sc = WIN ? (win_srccol(n0 >> 9) + (n0 & 511)) : n0;
#pragma unroll
            for (int i = 0; i < 8; ++i) v[q][i] = src[(size_t)(k0 + r8 + 8 * i) * src_ld + sc + c]; }
#pragma unroll
        for (int q = 0; q < 4; ++q)
#pragma unroll
            for (int i = 0; i < 8; ++i) *(LAS float*)(lds + q * 16640 + ((r8 + 8 * i) * 65 + c) * 4) = v[q][i];
        __syncthreads();
#pragma unroll
        for (int q = 0; q < 4; ++q) { const int u = u0 + q * G; if (u < nunits) { const int kt = u & ((1 << kshift) - 1), n0 = (u >> kshift) * 64, k0 = kt * 64;
#pragma unroll
            for (int i = 0; i < 8; ++i) { const int nn = r8 + 8 * i; dst[(size_t)(n0 + nn) * K + k0 + c] = f2bf(*(const LAS float*)(lds + q * 16640 + (c * 65 + nn) * 4)); } } }
        __syncthreads();
    }
}
__device__ __forceinline__ void convert_win(lds_t lds, const float* w_in_l, u16* WinT) { convert_mat<true>(lds, w_in_l, DIN, WinT, 1024, 4, 16 * 104); }
__device__ __forceinline__ void convert_wout(lds_t lds, const float* w_out_l, u16* WoutT) { convert_mat<false>(lds, w_out_l, 1024, WoutT, 2048, 5, 32 * 16); }
__device__ __forceinline__ float wave_sum(float v) {
#pragma unroll
    for (int m = 32; m >= 1; m >>= 1) v += __shfl_xor(v, m);
    return v;
}
__device__ __forceinline__ void row_pass(lds_t lds, const float* xin, float* xout, u16* yh, bool has_y, const float* post_g, bool has_next, const float* pre_g, const float* w_in_next, float* dtraw, bool dry) {
    const int tid = otid(), wid = tid >> 6, lane = tid & 63;
    if (has_next) { for (int i = tid; i < 8192; i += NTHR) { const int k = i >> 3, j = i & 7; *(LAS float*)(lds + (j * 1024 + k) * 4) = w_in_next[(size_t)k * DIN + 3584 + j]; } }
    __syncthreads();
    const int stride = gridDim.x * 8;
    int row = blockIdx.x * 8 + wid;
    f32x4 nx[4]; u32x2 ny[4];
#pragma unroll
    for (int i = 0; i < 4; ++i) { nx[i] = (f32x4){0.f, 0.f, 0.f, 0.f}; ny[i] = (u32x2){0u, 0u}; }
    if (row < T_TOK) {
#pragma unroll
        for (int i = 0; i < 4; ++i) { nx[i] = *(const f32x4*)(xin + (size_t)row * DM + i * 256 + lane * 4); if (has_y) ny[i] = *(const u32x2*)(yh + (size_t)row * DM + i * 256 + lane * 4); } }
    for (; row < T_TOK; row += stride) {
        f32x4 xv[4]; u32x2 yw[4];
#pragma unroll
        for (int i = 0; i < 4; ++i) { xv[i] = nx[i]; yw[i] = ny[i]; }
        const int nrow = row + stride;
        if (nrow < T_TOK) {
#pragma unroll
            for (int i = 0; i < 4; ++i) { nx[i] = *(const f32x4*)(xin + (size_t)nrow * DM + i * 256 + lane * 4); if (has_y) ny[i] = *(const u32x2*)(yh + (size_t)nrow * DM + i * 256 + lane * 4); } }
        if (has_y) {
            f32x4 yv[4]; float ss = 0.f;
#pragma unroll
            for (int i = 0; i < 4; ++i) { yv[i] = (f32x4){bflo(yw[i][0]), bfhi(yw[i][0]), bflo(yw[i][1]), bfhi(yw[i][1])}; ss += yv[i][0] * yv[i][0] + yv[i][1] * yv[i][1] + yv[i][2] * yv[i][2] + yv[i][3] * yv[i][3]; }
            ss = wave_sum(ss); const float r1 = rsqrtf(ss * (1.f / 1024.f) + EPS);
#pragma unroll
            for (int i = 0; i < 4; ++i) { const f32x4 g = *(const f32x4*)(post_g + i * 256 + lane * 4); xv[i] += yv[i] * r1 * g; if (!dry) *(f32x4*)(xout + (size_t)row * DM + i * 256 + lane * 4) = xv[i]; }
        }
        if (has_next) {
            float ss = 0.f;
#pragma unroll
            for (int i = 0; i < 4; ++i) ss += xv[i][0] * xv[i][0] + xv[i][1] * xv[i][1] + xv[i][2] * xv[i][2] + xv[i][3] * xv[i][3];
            ss = wave_sum(ss); const float r2 = rsqrtf(ss * (1.f / 1024.f) + EPS);
            float d[8];
#pragma unroll
            for (int j = 0; j < 8; ++j) d[j] = 0.f;
#pragma unroll
            for (int i = 0; i < 4; ++i) { const f32x4 g = *(const f32x4*)(pre_g + i * 256 + lane * 4); const f32x4 h = xv[i] * r2 * g;
                u32x2 w; w[0] = pk2(h[0], h[1]); w[1] = pk2(h[2], h[3]); if (!dry) *(u32x2*)(yh + (size_t)row * DM + i * 256 + lane * 4) = w;
#pragma unroll
                for (int j = 0; j < 8; ++j) { const f32x4 wv = *(const LAS f32x4*)(lds + (j * 1024 + i * 256 + lane * 4) * 4); d[j] += h[0] * wv[0] + h[1] * wv[1] + h[2] * wv[2] + h[3] * wv[3]; } }
            const bool b5 = (lane & 32) != 0, b4 = (lane & 16) != 0, b3 = (lane & 8) != 0;
            float e[4], f[2];
#pragma unroll
            for (int j = 0; j < 4; ++j) { const float snd = b5 ? d[j] : d[j + 4], kp = b5 ? d[j + 4] : d[j]; e[j] = kp + __shfl_xor(snd, 32); }
#pragma unroll
            for (int j = 0; j < 2; ++j) { const float snd = b4 ? e[j] : e[j + 2], kp = b4 ? e[j + 2] : e[j]; f[j] = kp + __shfl_xor(snd, 16); }
            float gsum; { const float snd = b3 ? f[0] : f[1], kp = b3 ? f[1] : f[0]; gsum = kp + __shfl_xor(snd, 8); }
            gsum += __shfl_xor(gsum, 4); gsum += __shfl_xor(gsum, 2); gsum += __shfl_xor(gsum, 1);
            if ((lane & 7) == 0 && !dry) dtraw[(size_t)row * 8 + (b5 ? 4 : 0) + (b4 ? 2 : 0) + (b3 ? 1 : 0)] = gsum;
        }
    }
    __syncthreads();
}

__device__ __forceinline__ void phase_prep(lds_t lds, const Params& p) {
    u16* WinT = (u16*)(p.ws + WS_WIN); u16* WoutT = (u16*)(p.ws + WS_WOUT);
    u16* memn = (u16*)p.out; u16* WkvT = (u16*)p.out + 2 * 1024 * 1024;
    float* rc = (float*)(p.ws + WS_ROPE); float* rs = rc + SEQ * 64;
    convert_win(lds, p.w_in, WinT);
    convert_wout(lds, p.w_out, WoutT);
    convert_mat<false>(lds, p.w_mem_kv, 1024, WkvT, 1024, 4, 256);
    convert_mat<false>(lds, p.w_mem_kv + (size_t)1024 * 1024, 1024, WkvT + (size_t)1024 * 1024, 1024, 4, 256);
    for (int i = blockIdx.x * NTHR + otid(); i < SEQ * 64; i += gridDim.x * NTHR) { const int pos = i >> 6, f = i & 63;
        const float inv = exp2f(-(float)f * 0.20762050593046015f);
        const float ang = (float)pos * inv;
        const float kq = rintf(ang * 0.15915494309189535f);
        float rf = fmaf(-kq, 6.2831854820251465f, ang); rf = fmaf(-kq, -1.7484555e-7f, rf);
        rc[i] = __cosf(rf); rs[i] = __sinf(rf); }
    { const int wid = otid() >> 6, lane = otid() & 63;
      for (int row = blockIdx.x * 8 + wid; row < 2048; row += gridDim.x * 8) { const int l = row >> 10, r = row & 1023;
          f32x4 xv[4]; float ss = 0.f;
#pragma unroll
          for (int i = 0; i < 4; ++i) { xv[i] = *(const f32x4*)(p.mem + (size_t)r * DM + i * 256 + lane * 4); ss += xv[i][0] * xv[i][0] + xv[i][1] * xv[i][1] + xv[i][2] * xv[i][2] + xv[i][3] * xv[i][3]; }
          ss = wave_sum(ss); const float r2 = rsqrtf(ss * (1.f / 1024.f) + EPS);
#pragma unroll
          for (int i = 0; i < 4; ++i) { const f32x4 g = *(const f32x4*)(p.mem_norm_g + l * 1024 + i * 256 + lane * 4); const f32x4 h = xv[i] * r2 * g;
              u32x2 w; w[0] = pk2(h[0], h[1]); w[1] = pk2(h[2], h[3]); *(u32x2*)(memn + (size_t)row * DM + i * 256 + lane * 4) = w; } } }
    row_pass(lds, p.x, nullptr, (u16*)(p.ws + WS_ST), false, nullptr, true, p.pre_g, p.w_in, (float*)(p.ws + WS_DT), false);
}

__device__ __forceinline__ float ret_log2g(int h) { return log2f(1.f - exp2f(-5.f - (float)h)); }

__device__ __forceinline__ bf16x8 pack8(const f32x4& a, const f32x4& b) {
    u32x4 w; w[0] = pk2(a[0], a[1]); w[1] = pk2(a[2], a[3]); w[2] = pk2(b[0], b[1]); w[3] = pk2(b[2], b[3]); return __builtin_bit_cast(bf16x8, w);
}
__device__ __forceinline__ bf16x8 frag_vtl(lds_t base, int ld, int e0, int k2, int fr, int fq) {
    lds_t p = base + ((32 * k2 + 4 * fq + (fr >> 2)) * ld + e0 + 4 * (fr & 3)) * 2;
    const s16x4 lo = trrd(p), hi = trrd(p + 16 * ld * 2);
    return (bf16x8){lo[0], lo[1], lo[2], lo[3], hi[0], hi[1], hi[2], hi[3]};
}
__device__ __forceinline__ bf16x8 frag_vt(lds_t base, int e0, int k2, int fr, int fq) {
    lds_t p = base + ((32 * k2 + 4 * fq + (fr >> 2)) * 136 + e0 + 4 * (fr & 3)) * 2;
    const s16x4 lo = trrd(p), hi = trrd(p + 16 * 136 * 2);
    return (bf16x8){lo[0], lo[1], lo[2], lo[3], hi[0], hi[1], hi[2], hi[3]};
}
__device__ __forceinline__ void sb_item(lds_t lds, u16* proj, int it, bool dry) {
    const int tid = otid(), wid = tid >> 6, lane = tid & 63, fr = lane & 15, fq = lane >> 4;
    const int qb = it & 63, h = (it >> 6) & 3, b = it >> 8;
    const size_t tok0 = (size_t)b * SEQ + qb * 128;
    lds_t Ks = lds, Vs = lds + 17408, red = lds + 35840;
    const int tpos = qb * 128 + 16 * wid + fr;
    bf16x8 qf[4];
    {
#pragma unroll
      for (int ks = 0; ks < 4; ++ks) qf[ks] = __builtin_bit_cast(bf16x8, *(const u32x4*)PJ(proj, tok0 + 16 * wid + fr, C_SQ + h * 128 + 8 * fq + 32 * ks)); }
    const int sr = (tid >> 2) & 31, sc = ((tid >> 7) << 2) | (tid & 3);
    u32x4 kr0, kr1, vr0, vr1;
    { const size_t t0 = (size_t)b * SEQ + (2 * qb + 1) * 64 + sr; const u16* kp = PJ(proj, t0, C_SK + h * 128 + sc * 8); const size_t vo = (size_t)((C_SV - C_SK) >> 5) * STRM;
      kr0 = *(const u32x4*)(kp); kr1 = *(const u32x4*)(kp + 32 * 32); vr0 = *(const u32x4*)(kp + vo); vr1 = *(const u32x4*)(kp + vo + 32 * 32); }
    __syncthreads();
    *(LAS u32x4*)(Ks + (sr * 136 + sc * 8) * 2) = kr0; *(LAS u32x4*)(Ks + ((sr + 32) * 136 + sc * 8) * 2) = kr1;
    *(LAS u32x4*)(Vs + (sr * 144 + sc * 8) * 2) = vr0; *(LAS u32x4*)(Vs + ((sr + 32) * 144 + sc * 8) * 2) = vr1;
    __syncthreads();
    f32x4 O[8], carry = (f32x4){0.f, 0.f, 0.f, 0.f};
#pragma unroll
    for (int n = 0; n < 8; ++n) O[n] = (f32x4){0.f, 0.f, 0.f, 0.f};
    const bf16x8 ones = (bf16x8){0x3F80, 0x3F80, 0x3F80, 0x3F80, 0x3F80, 0x3F80, 0x3F80, 0x3F80};
    bf16x8 U00, U10;
#pragma unroll
    for (int jj = 0; jj < 8; ++jj) { const int j = (jj < 4 ? 4 * fq + jj : 16 + 4 * fq + jj - 4); U00[jj] = (j > fr) ? (short)0x3F80 : (short)0; U10[jj] = (j > 16 + fr) ? (short)0x3F80 : (short)0; }
    float wmax = 0.f;
    for (int kb = 2 * qb + 1; kb >= 0; --kb) {
        if (kb > 0) { const size_t t0 = (size_t)b * SEQ + (kb - 1) * 64 + sr; const u16* kp = PJ(proj, t0, C_SK + h * 128 + sc * 8); const size_t vo = (size_t)((C_SV - C_SK) >> 5) * STRM;
            kr0 = *(const u32x4*)(kp); kr1 = *(const u32x4*)(kp + 32 * 32); vr0 = *(const u32x4*)(kp + vo); vr1 = *(const u32x4*)(kp + vo + 32 * 32); }
        const bool active = (kb * 64 < qb * 128 + 16 * wid + 15) && !(wmax < -110.f);
        if (active) {
        f32x4 S[4];
        { bf16x8 kf[16];
#pragma unroll
          for (int u = 0; u < 16; ++u) kf[u] = frag_row(Ks, 136, 16 * (u & 3), 32 * (u >> 2), fr, fq);
          __builtin_amdgcn_sched_barrier(0);
#pragma unroll
          for (int n = 0; n < 4; ++n) S[n] = (f32x4){0.f, 0.f, 0.f, 0.f};
#pragma unroll
          for (int ks = 0; ks < 4; ++ks)
#pragma unroll
              for (int n = 0; n < 4; ++n) S[n] = MFMA16(kf[4 * ks + n], qf[ks], S[n]);
          __builtin_amdgcn_sched_barrier(0); }
        bf16x8 vf[16];
#pragma unroll
        for (int u = 0; u < 16; ++u) vf[u] = frag_vtl(Vs, 144, 16 * (u & 7), u >> 3, fr, fq);
        __builtin_amdgcn_sched_barrier(0);
        f32x4 E[4], Lh[4], Ll[4];
#pragma unroll
        for (int n = 0; n < 4; ++n) { const int sbase = kb * 64 + 16 * n + 4 * fq;
#pragma unroll
            for (int r = 0; r < 4; ++r) { const float xx = S[n][r] * 0.08838834764831845f; const float lg = __logf(1.f + __expf(-fabsf(xx)));
                const float L = -fmaxf(xx, 0.f) - lg; E[n][r] = fminf(xx, 0.f) - lg;
                const float Lm = (sbase + r < tpos) ? L : 0.f; const float hi = bf2f(f2bf(Lm));
                Lh[n][r] = hi; Ll[n][r] = Lm - hi; } }
        const bf16x8 bh0 = pack8(Lh[0], Lh[1]), bh1 = pack8(Lh[2], Lh[3]), bl0 = pack8(Ll[0], Ll[1]), bl1 = pack8(Ll[2], Ll[3]);
        f32x4 tail[4];
#pragma unroll
        for (int n = 0; n < 4; ++n) tail[n] = carry;
        tail[0] = MFMA16(U00, bh0, tail[0]); tail[0] = MFMA16(U00, bl0, tail[0]); tail[0] = MFMA16(ones, bh1, tail[0]); tail[0] = MFMA16(ones, bl1, tail[0]);
        tail[1] = MFMA16(U10, bh0, tail[1]); tail[1] = MFMA16(U10, bl0, tail[1]); tail[1] = MFMA16(ones, bh1, tail[1]); tail[1] = MFMA16(ones, bl1, tail[1]);
        tail[2] = MFMA16(U00, bh1, tail[2]); tail[2] = MFMA16(U00, bl1, tail[2]);
        tail[3] = MFMA16(U10, bh1, tail[3]); tail[3] = MFMA16(U10, bl1, tail[3]);
        carry = MFMA16(ones, bh0, carry); carry = MFMA16(ones, bl0, carry); carry = MFMA16(ones, bh1, carry); carry = MFMA16(ones, bl1, carry);
        f32x4 W[4];
#pragma unroll
        for (int n = 0; n < 4; ++n) { const int sbase = kb * 64 + 16 * n + 4 * fq;
#pragma unroll
            for (int r = 0; r < 4; ++r) W[n][r] = (sbase + r < tpos) ? __expf(E[n][r] + tail[n][r]) : 0.f; }
        const bf16x8 bw0 = pack8(W[0], W[1]), bw1 = pack8(W[2], W[3]);
#pragma unroll
        for (int n = 0; n < 8; ++n) O[n] = MFMA16(vf[n], bw0, O[n]);
#pragma unroll
        for (int n = 0; n < 8; ++n) O[n] = MFMA16(vf[8 + n], bw1, O[n]);
        { float m = carry[0]; m = fmaxf(m, __shfl_xor(m, 1)); m = fmaxf(m, __shfl_xor(m, 2)); m = fmaxf(m, __shfl_xor(m, 4)); m = fmaxf(m, __shfl_xor(m, 8)); wmax = m; }
        }
        if (lane == 0) *(LAS float*)(red + wid * 4) = wmax;
        __syncthreads();
        float bm = *(const LAS float*)(red);
#pragma unroll
        for (int w = 1; w < 8; ++w) bm = fmaxf(bm, *(const LAS float*)(red + w * 4));
        if (bm < -110.f || kb == 0) break;
        *(LAS u32x4*)(Ks + (sr * 136 + sc * 8) * 2) = kr0; *(LAS u32x4*)(Ks + ((sr + 32) * 136 + sc * 8) * 2) = kr1;
        *(LAS u32x4*)(Vs + (sr * 144 + sc * 8) * 2) = vr0; *(LAS u32x4*)(Vs + ((sr + 32) * 144 + sc * 8) * 2) = vr1;
        __syncthreads();
    }
#pragma unroll
    for (int n = 0; n < 8; ++n) { u16* gp = PJ(proj, tok0 + 16 * wid + fr, C_SG + h * 128 + 4 * fq + 16 * n); const u32x2 gv = *(const u32x2*)(gp); u32x2 o;
        o[0] = pk2(O[n][0] * siluf(bflo(gv[0])), O[n][1] * siluf(bfhi(gv[0]))); o[1] = pk2(O[n][2] * siluf(bflo(gv[1])), O[n][3] * siluf(bfhi(gv[1])));
        if (!dry) *(u32x2*)(gp) = o; }
}

__device__ __forceinline__ void mem_group(lds_t lds, u16* proj, const u16* memkv, bool dry) {
    const int tid = otid(), wid = tid >> 6, lane = tid & 63, fr = lane & 15, fq = lane >> 4;
    lds_t Km = lds, Vm = lds + 69632;
    int cur_bh = -1;
    for (int idx = blockIdx.x * 4; idx < 1024; idx += gridDim.x * 4) {
        const int bh = idx >> 6, b = bh >> 2, h = bh & 3;
        if (bh != cur_bh) { __syncthreads();
            copy_tile(Km, 136, memkv + (size_t)b * 256 * 1024 + h * 128, 1024, 256, 4);
            copy_tile(Vm, 144, memkv + (size_t)b * 256 * 1024 + 512 + h * 128, 1024, 256, 4);
            __syncthreads(); cur_bh = bh; }
        u32x4 qn[4];
        {
#pragma unroll
          for (int ks = 0; ks < 4; ++ks) qn[ks] = *(const u32x4*)PJ(proj, (size_t)b * SEQ + (idx & 63) * 128 + 16 * wid + fr, C_MQ + h * 128 + 8 * fq + 32 * ks); }
#pragma unroll 1
        for (int j = 0; j < 4; ++j) { const int tile = (idx + j) & 63;
            const size_t tok = (size_t)b * SEQ + tile * 128 + 16 * wid + fr;
            bf16x8 qf[4];
#pragma unroll
            for (int ks = 0; ks < 4; ++ks) qf[ks] = __builtin_bit_cast(bf16x8, qn[ks]);
            if (j < 3) {
#pragma unroll
                for (int ks = 0; ks < 4; ++ks) qn[ks] = *(const u32x4*)PJ(proj, tok + 128, C_MQ + h * 128 + 8 * fq + 32 * ks); }
            u32x2 gv[8];
#pragma unroll
            for (int n = 0; n < 8; ++n) gv[n] = *(const u32x2*)PJ(proj, tok, C_MG + h * 128 + 4 * fq + 16 * n);
            f32x4 S[16];
            { bf16x8 kf[2][8];
#pragma unroll
              for (int u = 0; u < 8; ++u) kf[0][u] = frag_row(Km, 136, 16 * (u >> 2), 32 * (u & 3), fr, fq);
#pragma unroll
              for (int np = 0; np < 8; ++np) {
                  if (np + 1 < 8) {
#pragma unroll
                      for (int u = 0; u < 8; ++u) kf[(np + 1) & 1][u] = frag_row(Km, 136, 16 * (2 * np + 2 + (u >> 2)), 32 * (u & 3), fr, fq); }
                  __builtin_amdgcn_sched_barrier(0);
                  S[2 * np] = (f32x4){0.f, 0.f, 0.f, 0.f}; S[2 * np + 1] = (f32x4){0.f, 0.f, 0.f, 0.f};
#pragma unroll
                  for (int ks = 0; ks < 4; ++ks) { S[2 * np] = MFMA16(kf[np & 1][ks], qf[ks], S[2 * np]); S[2 * np + 1] = MFMA16(kf[np & 1][4 + ks], qf[ks], S[2 * np + 1]); }
                  __builtin_amdgcn_sched_barrier(0); } }
            float m = S[0][0];
#pragma unroll
            for (int n = 0; n < 16; ++n)
#pragma unroll
                for (int r = 0; r < 4; ++r) m = fmaxf(m, S[n][r]);
            m = fmaxf(m, __shfl_xor(m, 16)); m = fmaxf(m, __shfl_xor(m, 32));
            float s = 0.f;
#pragma unroll
            for (int n = 0; n < 16; ++n)
#pragma unroll
                for (int r = 0; r < 4; ++r) { const float e = __expf((S[n][r] - m) * 0.08838834764831845f); S[n][r] = e; s += e; }
            s += __shfl_xor(s, 16); s += __shfl_xor(s, 32);
            const float inv = 1.f / s;
            f32x4 O[8];
#pragma unroll
            for (int n = 0; n < 8; ++n) O[n] = (f32x4){0.f, 0.f, 0.f, 0.f};
            { bf16x8 af[2][8];
#pragma unroll
              for (int n = 0; n < 8; ++n) af[0][n] = frag_vtl(Vm, 144, 16 * n, 0, fr, fq);
#pragma unroll
              for (int k2 = 0; k2 < 8; ++k2) { const bf16x8 bp = pack8(S[2 * k2], S[2 * k2 + 1]);
                  if (k2 + 1 < 8) {
#pragma unroll
                      for (int n = 0; n < 8; ++n) af[(k2 + 1) & 1][n] = frag_vtl(Vm, 144, 16 * n, k2 + 1, fr, fq); }
                  __builtin_amdgcn_sched_barrier(0);
#pragma unroll
                  for (int n = 0; n < 8; ++n) O[n] = MFMA16(af[k2 & 1][n], bp, O[n]);
                  __builtin_amdgcn_sched_barrier(0); } }
#pragma unroll
            for (int n = 0; n < 8; ++n) { u16* gp = PJ(proj, tok, C_MG + h * 128 + 4 * fq + 16 * n); u32x2 o;
                o[0] = pk2(O[n][0] * inv * siluf(bflo(gv[n][0])), O[n][1] * inv * siluf(bfhi(gv[n][0]))); o[1] = pk2(O[n][2] * inv * siluf(bflo(gv[n][1])), O[n][3] * inv * siluf(bfhi(gv[n][1])));
                if (!dry) *(u32x2*)(gp) = o; }
        }
    }
    __syncthreads();
}

__device__ __forceinline__ void ret_state_item(lds_t lds, const u16* proj, u16* retS, const float* rc, const float* rs, int it) {
    const int tid = otid(), wid = tid >> 6, lane = tid & 63, fr = lane & 15, fq = lane >> 4, wr = wid >> 1, wc = wid & 1;
    const int h = it & 3, bc = it >> 2, c = bc & 63, b = bc >> 6;
    const size_t tok0 = (size_t)b * SEQ + c * 128;
    lds_t KZ = lds, Vs = lds + 34816;
    __syncthreads();
    rope_tile(KZ, proj, tok0, C_RK + h * 128, rc, rs, c * 128, 0.08838834764831845f, ret_log2g(h));
    copy_tile_pj(Vs, 136, proj, tok0, C_RV + h * 128);
    __syncthreads();
    f32x4 acc[2][4];
#pragma unroll
    for (int m = 0; m < 2; ++m)
#pragma unroll
        for (int n = 0; n < 4; ++n) acc[m][n] = (f32x4){0.f, 0.f, 0.f, 0.f};
#pragma unroll
    for (int ks = 0; ks < 4; ++ks) { bf16x8 a[2], bq[4];
#pragma unroll
        for (int m = 0; m < 2; ++m) a[m] = frag_tr(Vs, 136, 32 * wr + 16 * m, 32 * ks, fr, fq);
#pragma unroll
        for (int n = 0; n < 4; ++n) bq[n] = frag_tr(KZ, 136, 64 * wc + 16 * n, 32 * ks, fr, fq);
#pragma unroll
        for (int m = 0; m < 2; ++m)
#pragma unroll
            for (int n = 0; n < 4; ++n) acc[m][n] = MFMA16(a[m], bq[n], acc[m][n]); }
    u16* dst = retS + (size_t)it * 16384;
#pragma unroll
    for (int m = 0; m < 2; ++m)
#pragma unroll
        for (int n = 0; n < 4; ++n)
#pragma unroll
            for (int r = 0; r < 4; ++r) dst[(32 * wr + 16 * m + 4 * fq + r) * 128 + 64 * wc + 16 * n + fr] = f2bf(acc[m][n][r]);
}

__device__ __forceinline__ void ssd_dt(lds_t acs, lds_t dlt, const float* dtraw, const float* dt_bias, const float* a_log, size_t tok0, int g) {
    const int tid = otid();
    { const int t = tid >> 2, hh = tid & 3, h = 4 * g + hh;
      const float dr = dtraw[(tok0 + t) * 8 + h] + dt_bias[h];
      const float delta = dr > 20.f ? dr : log1pf(__expf(dr));
      *(LAS float*)(dlt + tid * 4) = delta; *(LAS float*)(acs + tid * 4) = -delta * __expf(a_log[h]); }
    __syncthreads();
    if (tid < 256) { const int hh = tid >> 6, ln = tid & 63;
        const float v0 = *(const LAS float*)(acs + ((2 * ln) * 4 + hh) * 4), v1 = *(const LAS float*)(acs + ((2 * ln + 1) * 4 + hh) * 4);
        float sc = v0 + v1;
#pragma unroll
        for (int d = 1; d < 64; d <<= 1) { const float o = __shfl_up(sc, d); if (ln >= d) sc += o; }
        *(LAS float*)(acs + ((2 * ln) * 4 + hh) * 4) = sc - v1; *(LAS float*)(acs + ((2 * ln + 1) * 4 + hh) * 4) = sc; }
    __syncthreads();
}

__device__ __forceinline__ void ssd_state_item(lds_t lds, const u16* proj, u16* ssdS, float* cdec, const float* dtraw, const float* cw, const float* cb, const float* dt_bias, const float* a_log, int it) {
    const int tid = otid(), wid = tid >> 6, lane = tid & 63, fr = lane & 15, fq = lane >> 4, wr = wid >> 1, wc = wid & 1;
    const int g = it & 1, bc = it >> 1, c = bc & 63, b = bc >> 6;
    const size_t tok0 = (size_t)b * SEQ + c * 128;
    lds_t Bm = lds, XW = lds + 34816, acs = lds + 102400, dlt = lds + 104448, scl = lds + 106496;
    __syncthreads();
    ssd_dt(acs, dlt, dtraw, dt_bias, a_log, tok0, g);
    { const int hh = tid & 3; const float al = *(const LAS float*)(acs + (127 * 4 + hh) * 4);
      *(LAS float*)(scl + tid * 4) = *(const LAS float*)(dlt + tid * 4) * __expf(al - *(const LAS float*)(acs + tid * 4));
      if (tid < 4) cdec[(size_t)bc * 8 + 4 * g + tid] = __expf(al); }
    __syncthreads();
    conv_tile<16, false>(Bm, 136, proj, tok0, c * 128, 512 + g * 128, cw, cb, scl);
    conv_tile<32, true>(XW, 264, proj, tok0, c * 128, g * 256, cw, cb, scl);
    __syncthreads();
    u16* dst = ssdS + ((size_t)bc * 8 + 4 * g + wr) * 8192;
#pragma unroll 1
    for (int nh = 0; nh < 2; ++nh) {
        f32x4 acc[4][2];
#pragma unroll
        for (int m = 0; m < 4; ++m)
#pragma unroll
            for (int n = 0; n < 2; ++n) acc[m][n] = (f32x4){0.f, 0.f, 0.f, 0.f};
#pragma unroll
        for (int ks = 0; ks < 4; ++ks) { bf16x8 a[4], bq[2];
#pragma unroll
            for (int m = 0; m < 4; ++m) a[m] = frag_tr(XW, 264, 64 * wr + 16 * m, 32 * ks, fr, fq);
#pragma unroll
            for (int n = 0; n < 2; ++n) bq[n] = frag_tr(Bm, 136, 64 * wc + 32 * nh + 16 * n, 32 * ks, fr, fq);
#pragma unroll
            for (int m = 0; m < 4; ++m)
#pragma unroll
                for (int n = 0; n < 2; ++n) acc[m][n] = MFMA16(a[m], bq[n], acc[m][n]); }
#pragma unroll
        for (int m = 0; m < 4; ++m)
#pragma unroll
            for (int n = 0; n < 2; ++n)
#pragma unroll
                for (int r = 0; r < 4; ++r) dst[(16 * m + 4 * fq + r) * 128 + 64 * wc + 32 * nh + 16 * n + fr] = f2bf(acc[m][n][r]);
    }
}

__device__ __forceinline__ void scan_phase(u16* retS, u16* ssdS, const float* cdec, bool dry) {
    const int tid = otid();
    if (tid >= 256) return;
    for (int q = blockIdx.x * 256 + tid; q < 65536; q += gridDim.x * 256) {
        float st[8];
#pragma unroll
        for (int e = 0; e < 8; ++e) st[e] = 0.f;
        u16* p; const float* dp = nullptr; float dec0 = 0.f;
        if (q < 32768) { const int bh = q >> 11, e8 = q & 2047, b = bh >> 2, h = bh & 3;
            dec0 = exp2f(128.f * ret_log2g(h));
            p = retS + ((size_t)(b * 64) * 4 + h) * 16384 + e8 * 8;
        } else { const int q2 = q - 32768, bh = q2 >> 10, e8 = q2 & 1023, b = bh >> 3, h = bh & 7;
            p = ssdS + ((size_t)(b * 64) * 8 + h) * 8192 + e8 * 8; dp = cdec + (size_t)(b * 64) * 8 + h; }
#pragma unroll 16
        for (int c = 0; c < 64; ++c) { u32x4* pp = (u32x4*)(p + (size_t)c * 65536); const u32x4 v = *pp; const float dec = dp ? dp[c * 8] : dec0;
            u32x4 o;
#pragma unroll
            for (int e = 0; e < 4; ++e) o[e] = pk2(st[2 * e], st[2 * e + 1]);
            *pp = o;
#pragma unroll
            for (int e = 0; e < 4; ++e) { st[2 * e] = dec * st[2 * e] + bflo(v[e]); st[2 * e + 1] = dec * st[2 * e + 1] + bfhi(v[e]); } }
    }
}

__device__ __forceinline__ void ret_out_item(lds_t lds, u16* proj, const u16* retS, const float* rc, const float* rs, int it, bool dry) {
    const int tid = otid(), wid = tid >> 6, lane = tid & 63, fr = lane & 15, fq = lane >> 4, wr = wid >> 1, wc = wid & 1;
    const int h = it & 3, bc = it >> 2, c = bc & 63, b = bc >> 6;
    const size_t tok0 = (size_t)b * SEQ + c * 128;
    const float l2g = ret_log2g(h);
    lds_t Qs = lds, Ks = lds + 34816, Vs = lds + 69632, Rs = lds + 104448, Ys = lds;
    __syncthreads();
    rope_tile(Qs, proj, tok0, C_RQ + h * 128, rc, rs, c * 128, 1.f, 0.f);
    rope_tile(Ks, proj, tok0, C_RK + h * 128, rc, rs, c * 128, 0.08838834764831845f, 0.f);
    copy_tile_pj(Vs, 136, proj, tok0, C_RV + h * 128);
    copy_tile(Rs, 136, retS + (size_t)it * 16384, 128, 128, 4);
    __syncthreads();
    f32x4 a1[2][4], a2[2][4];
#pragma unroll
    for (int m = 0; m < 2; ++m)
#pragma unroll
        for (int n = 0; n < 4; ++n) { a1[m][n] = (f32x4){0.f, 0.f, 0.f, 0.f}; a2[m][n] = (f32x4){0.f, 0.f, 0.f, 0.f}; }
    { bf16x8 fb[2][10];
#pragma unroll
      for (int u = 0; u < 10; ++u) fb[0][u] = (u < 2) ? frag_row(Qs, 136, 32 * wr + 16 * u, 0, fr, fq) : (u < 6) ? frag_row(Ks, 136, 64 * wc + 16 * (u - 2), 0, fr, fq) : frag_row(Rs, 136, 64 * wc + 16 * (u - 6), 0, fr, fq);
#pragma unroll
      for (int ks = 0; ks < 4; ++ks) {
          if (ks + 1 < 4) {
#pragma unroll
              for (int u = 0; u < 10; ++u) fb[(ks + 1) & 1][u] = (u < 2) ? frag_row(Qs, 136, 32 * wr + 16 * u, 32 * (ks + 1), fr, fq) : (u < 6) ? frag_row(Ks, 136, 64 * wc + 16 * (u - 2), 32 * (ks + 1), fr, fq) : frag_row(Rs, 136, 64 * wc + 16 * (u - 6), 32 * (ks + 1), fr, fq); }
          __builtin_amdgcn_sched_barrier(0);
#pragma unroll
          for (int n = 0; n < 4; ++n)
#pragma unroll
              for (int m = 0; m < 2; ++m) { a1[m][n] = MFMA16(fb[ks & 1][m], fb[ks & 1][2 + n], a1[m][n]); a2[m][n] = MFMA16(fb[ks & 1][m], fb[ks & 1][6 + n], a2[m][n]); }
          __builtin_amdgcn_sched_barrier(0); } }
    __syncthreads();
#pragma unroll
    for (int m = 0; m < 2; ++m)
#pragma unroll
        for (int n = 0; n < 4; ++n)
#pragma unroll
            for (int r = 0; r < 4; ++r) { const int l = 32 * wr + 16 * m + 4 * fq + r, mm = 64 * wc + 16 * n + fr;
                const float pv = (l >= mm) ? a1[m][n][r] * exp2f(l2g * (float)(l - mm)) : 0.f;
                *(LAS u16*)(Ks + (l * 136 + mm) * 2) = f2bf(pv); }
    __syncthreads();
#pragma unroll
    for (int m = 0; m < 2; ++m)
#pragma unroll
        for (int n = 0; n < 4; ++n) a1[m][n] = (f32x4){0.f, 0.f, 0.f, 0.f};
    { bf16x8 fb[2][6];
#pragma unroll
      for (int u = 0; u < 6; ++u) fb[0][u] = (u < 2) ? frag_row(Ks, 136, 32 * wr + 16 * u, 0, fr, fq) : frag_tr(Vs, 136, 64 * wc + 16 * (u - 2), 0, fr, fq);
#pragma unroll
      for (int ks = 0; ks < 4; ++ks) {
          if (ks + 1 < 4) {
#pragma unroll
              for (int u = 0; u < 6; ++u) fb[(ks + 1) & 1][u] = (u < 2) ? frag_row(Ks, 136, 32 * wr + 16 * u, 32 * (ks + 1), fr, fq) : frag_tr(Vs, 136, 64 * wc + 16 * (u - 2), 32 * (ks + 1), fr, fq); }
          __builtin_amdgcn_sched_barrier(0);
#pragma unroll
          for (int n = 0; n < 4; ++n)
#pragma unroll
              for (int m = 0; m < 2; ++m) a1[m][n] = MFMA16(fb[ks & 1][m], fb[ks & 1][2 + n], a1[m][n]);
          __builtin_amdgcn_sched_barrier(0); } }
    __syncthreads();
#pragma unroll
    for (int m = 0; m < 2; ++m)
#pragma unroll
        for (int r = 0; r < 4; ++r) { const int l = 32 * wr + 16 * m + 4 * fq + r; const float xi = exp2f(l2g * (float)(l + 1));
#pragma unroll
            for (int n = 0; n < 4; ++n) *(LAS float*)(Ys + (l * 132 + 64 * wc + 16 * n + fr) * 4) = a1[m][n][r] + xi * a2[m][n][r]; }
    __syncthreads();
    { const int r = tid >> 2, q4 = tid & 3; float v[32]; float s = 0.f;
#pragma unroll
      for (int i = 0; i < 8; ++i) { const f32x4 t = *(const LAS f32x4*)(Ys + (r * 132 + q4 * 32 + i * 4) * 4); v[4 * i] = t[0]; v[4 * i + 1] = t[1]; v[4 * i + 2] = t[2]; v[4 * i + 3] = t[3]; s += t[0] + t[1] + t[2] + t[3]; }
      s += __shfl_xor(s, 1); s += __shfl_xor(s, 2); const float mu = s * (1.f / 128.f);
      float q = 0.f;
#pragma unroll
      for (int i = 0; i < 32; ++i) { v[i] -= mu; q += v[i] * v[i]; }
      q += __shfl_xor(q, 1); q += __shfl_xor(q, 2); const float rstd = rsqrtf(q * (1.f / 128.f) + EPS);
      u16* gp = PJ(proj, tok0 + r, C_RG + h * 128 + q4 * 32);
#pragma unroll
      for (int i = 0; i < 4; ++i) { const u32x4 gv = *(const u32x4*)(gp + i * 8); u32x4 o;
#pragma unroll
          for (int e = 0; e < 4; ++e) o[e] = pk2(v[8 * i + 2 * e] * rstd * siluf(bflo(gv[e])), v[8 * i + 2 * e + 1] * rstd * siluf(bfhi(gv[e])));
          if (!dry) *(u32x4*)(gp + i * 8) = o; } }
}

__device__ __forceinline__ bf16x8 frag_vt_ld(lds_t base, int ld, int e0, int k2, int fr, int fq) {
    lds_t p = base + ((32 * k2 + 4 * fq + (fr >> 2)) * ld + e0 + 4 * (fr & 3)) * 2;
    const s16x4 lo = trrd(p), hi = trrd(p + 16 * ld * 2);
    return (bf16x8){lo[0], lo[1], lo[2], lo[3], hi[0], hi[1], hi[2], hi[3]};
}
__device__ __forceinline__ void ssd_out_item(lds_t lds, u16* proj, const u16* ssdS, const float* dtraw, const float* cw, const float* cb, const float* dt_bias, const float* a_log,
                                             const float* d_skip, const float* norm_g, int it, bool dry) {
    const int tid = otid(), wid = tid >> 6, lane = tid & 63, fr = lane & 15, fq = lane >> 4;
    const int g = it & 1, bc = it >> 1, c = bc & 63, b = bc >> 6;
    const size_t tok0 = (size_t)b * SEQ + c * 128;
    lds_t Cs = lds, Bm = lds + 34816, XS = lds + 69632, acs = lds + 139264, dlt = lds + 141312, acsT = lds + 143360, dltT = lds + 145408, ssq = lds + 147456;
    __syncthreads();
    ssd_dt(acs, dlt, dtraw, dt_bias, a_log, tok0, g);
    { const int t = tid >> 2, hh = tid & 3; *(LAS float*)(acsT + (hh * 128 + t) * 4) = *(const LAS float*)(acs + tid * 4); *(LAS float*)(dltT + (hh * 128 + t) * 4) = *(const LAS float*)(dlt + tid * 4); }
    conv_tile<16, false>(Cs, 136, proj, tok0, c * 128, 768 + g * 128, cw, cb, acs);
    conv_tile<16, false>(Bm, 136, proj, tok0, c * 128, 512 + g * 128, cw, cb, acs);
    conv_tile<32, false>(XS, 272, proj, tok0, c * 128, g * 256, cw, cb, acs);
    __syncthreads();
    const int l = 16 * wid + fr;
    bf16x8 cf[4];
#pragma unroll
    for (int ks = 0; ks < 4; ++ks) cf[ks] = frag_row(Cs, 136, 16 * wid, 32 * ks, fr, fq);
    f32x4 cbT[8];
    { bf16x8 kf[2][8];
#pragma unroll
      for (int u = 0; u < 8; ++u) kf[0][u] = frag_row(Bm, 136, 16 * (u >> 2), 32 * (u & 3), fr, fq);
#pragma unroll
      for (int np = 0; np < 4; ++np) {
          if (np + 1 < 4) {
#pragma unroll
              for (int u = 0; u < 8; ++u) kf[(np + 1) & 1][u] = frag_row(Bm, 136, 16 * (2 * np + 2 + (u >> 2)), 32 * (u & 3), fr, fq); }
          __builtin_amdgcn_sched_barrier(0);
          cbT[2 * np] = (f32x4){0.f, 0.f, 0.f, 0.f}; cbT[2 * np + 1] = (f32x4){0.f, 0.f, 0.f, 0.f};
#pragma unroll
          for (int ks = 0; ks < 4; ++ks) { cbT[2 * np] = MFMA16(kf[np & 1][ks], cf[ks], cbT[2 * np]); cbT[2 * np + 1] = MFMA16(kf[np & 1][4 + ks], cf[ks], cbT[2 * np + 1]); }
          __builtin_amdgcn_sched_barrier(0); } }
    u16* gp = PJ(proj, tok0 + l, C_Z + g * 256 + 4 * fq);
#pragma unroll 1
    for (int hh = 0; hh < 4; ++hh) {
        const int h = 4 * g + hh;
        const u16* pv = ssdS + ((size_t)bc * 8 + h) * 8192 + (size_t)fr * 128 + 8 * fq;
        const float al = *(const LAS float*)(acsT + (hh * 128 + l) * 4);
        bf16x8 pf[16];
#pragma unroll
        for (int u = 0; u < 16; ++u) pf[u] = __builtin_bit_cast(bf16x8, *(const u32x4*)(pv + (size_t)(u >> 2) * 2048 + 32 * (u & 3)));
        bf16x8 bp[4];
#pragma unroll
        for (int k2 = 0; k2 < 4; ++k2) { f32x4 pa[2];
#pragma unroll
            for (int u = 0; u < 2; ++u) { const int n = 2 * k2 + u, s0 = 16 * n + 4 * fq;
                const f32x4 as = *(const LAS f32x4*)(acsT + (hh * 128 + s0) * 4), ds = *(const LAS f32x4*)(dltT + (hh * 128 + s0) * 4);
#pragma unroll
                for (int r = 0; r < 4; ++r) pa[u][r] = (s0 + r <= l) ? cbT[n][r] * __expf(al - as[r]) * ds[r] : 0.f; }
            bp[k2] = pack8(pa[0], pa[1]); }
        f32x4 yd[4], yo[4];
#pragma unroll
        for (int m = 0; m < 4; ++m) { yd[m] = (f32x4){0.f, 0.f, 0.f, 0.f}; yo[m] = (f32x4){0.f, 0.f, 0.f, 0.f}; }
#pragma unroll
        for (int hf = 0; hf < 2; ++hf) { bf16x8 xf[8];
#pragma unroll
            for (int u = 0; u < 8; ++u) xf[u] = frag_vt_ld(XS, 272, hh * 64 + 16 * (2 * hf + (u >> 2)), u & 3, fr, fq);
            __builtin_amdgcn_sched_barrier(0);
#pragma unroll
            for (int k2 = 0; k2 < 4; ++k2) { yd[2 * hf] = MFMA16(xf[k2], bp[k2], yd[2 * hf]); yd[2 * hf + 1] = MFMA16(xf[4 + k2], bp[k2], yd[2 * hf + 1]);
                yo[2 * hf] = MFMA16(pf[8 * hf + k2], cf[k2], yo[2 * hf]); yo[2 * hf + 1] = MFMA16(pf[8 * hf + 4 + k2], cf[k2], yo[2 * hf + 1]); }
            __builtin_amdgcn_sched_barrier(0); }
        const float dsk = d_skip[h], ea = __expf(al);
        float part = 0.f;
#pragma unroll
        for (int m = 0; m < 4; ++m) { const u32x2 xw = *(const LAS u32x2*)(XS + (l * 272 + hh * 64 + 16 * m + 4 * fq) * 2);
            u16* gz = PJ(proj, tok0 + l, C_Z + g * 256 + hh * 64 + 16 * m + 4 * fq);
            const u32x2 zw = *(const u32x2*)(gz);
            const float v0 = (yd[m][0] + ea * yo[m][0] + dsk * bflo(xw[0])) * siluf(bflo(zw[0])), v1 = (yd[m][1] + ea * yo[m][1] + dsk * bfhi(xw[0])) * siluf(bfhi(zw[0]));
            const float v2 = (yd[m][2] + ea * yo[m][2] + dsk * bflo(xw[1])) * siluf(bflo(zw[1])), v3 = (yd[m][3] + ea * yo[m][3] + dsk * bfhi(xw[1])) * siluf(bfhi(zw[1]));
            u32x2 o; o[0] = pk2(v0, v1); o[1] = pk2(v2, v3);
            if (!dry) *(u32x2*)(gz) = o;
            part += v0 * v0 + v1 * v1 + v2 * v2 + v3 * v3; }
        part += __shfl_xor(part, 16); part += __shfl_xor(part, 32);
        if (fq == 0) *(LAS float*)(ssq + (l * 4 + hh) * 4) = part;
    }
    __syncthreads();
    { const int r = tid >> 2, q4 = tid & 3;
      const f32x4 p0 = *(const LAS f32x4*)(ssq + r * 16);
      const float ss = p0[0] + p0[1] + p0[2] + p0[3];
      const float rr = rsqrtf(ss * (1.f / 256.f) + EPS);
      const int gqc = C_Z + g * 256 + q4 * 64;
      const float* ng = norm_g + g * 256 + q4 * 64;
#pragma unroll
      for (int i = 0; i < 8; ++i) { u16* gq = PJ(proj, tok0 + r, gqc + i * 8); const u32x4 zv = *(const u32x4*)(gq); const f32x4 g0 = *(const f32x4*)(ng + i * 8), g1 = *(const f32x4*)(ng + i * 8 + 4); u32x4 o;
          o[0] = pk2(bflo(zv[0]) * rr * g0[0], bfhi(zv[0]) * rr * g0[1]); o[1] = pk2(bflo(zv[1]) * rr * g0[2], bfhi(zv[1]) * rr * g0[3]);
          o[2] = pk2(bflo(zv[2]) * rr * g1[0], bfhi(zv[2]) * rr * g1[1]); o[3] = pk2(bflo(zv[3]) * rr * g1[2], bfhi(zv[3]) * rr * g1[3]);
          if (!dry) *(u32x4*)(gq) = o; } }
}

#define XB_TMO      128
#define XB_XCNT(j)  (256  + 64 * (j))
#define XB_XSUB(j)  (1280 + 64 * (j))
#define XB_XGEN(j)  (2304 + 64 * (j))
#define XB_TOP      3328
#define XB_TOPGEN   3392
#define XCD_BAR_WORDS 3456
#define XB_SPIN_CAP (1u << 18)

__device__ __forceinline__ unsigned xb_ld(unsigned* p)              { return __hip_atomic_load(p, __ATOMIC_RELAXED, __HIP_MEMORY_SCOPE_AGENT); }
__device__ __forceinline__ unsigned xb_add(unsigned* p, unsigned v) { return __hip_atomic_fetch_add(p, v, __ATOMIC_RELAXED, __HIP_MEMORY_SCOPE_AGENT); }
__device__ __forceinline__ unsigned xb_xcc_id() { return (unsigned)__builtin_amdgcn_s_getreg((3 << 11) | 20) & 0xFu; }
#define XB_SPIN(cond, bar) do { unsigned _sp = 0; while (cond) { __builtin_amdgcn_s_sleep(1); \
    if ((++_sp & 255u) == 0u) { if (xb_ld(&(bar)[XB_TMO])) break; if (_sp > XB_SPIN_CAP) { atomicAdd(&(bar)[XB_TMO], 1u); break; } } } } while (0)

struct XcdBarrier {
    unsigned* bar; unsigned x;
    volatile LAS unsigned* st;
};

__device__ __forceinline__ XcdBarrier xcd_barrier_post(unsigned* bar, volatile LAS unsigned* st) {
    XcdBarrier b; b.bar = bar; b.x = xb_xcc_id(); b.st = st;
    if (threadIdx.x == 0) (void)xb_add(&bar[XB_XCNT(b.x)], 1u);
    return b;
}
__device__ __forceinline__ void xcd_barrier_complete(unsigned* bar, unsigned x, unsigned& nloc, unsigned& nx) {
    const unsigned G = gridDim.x * gridDim.y * gridDim.z;
    unsigned sum, cnt, mine, sp = 0u;
    for (;;) {
        sum = 0u; cnt = 0u; mine = 0u;
#pragma unroll
        for (unsigned j = 0; j < 16; ++j) { const unsigned c = xb_ld(&bar[XB_XCNT(j)]); sum += c; cnt += (c > 0u) ? 1u : 0u; mine = (j == x) ? c : mine; }
        if (sum == G) break;
        __builtin_amdgcn_s_sleep(1);
        if ((++sp & 255u) == 0u) { if (xb_ld(&bar[XB_TMO])) break; if (sp > XB_SPIN_CAP) { atomicAdd(&bar[XB_TMO], 1u); break; } }
    }
    nloc = mine > 0u ? mine : 1u; nx = cnt > 0u ? cnt : 1u;
}

__device__ __forceinline__ void xcd_barrier(const XcdBarrier& b) {
    asm volatile("s_waitcnt vmcnt(0)" ::: "memory");
    __syncthreads();
    if (threadIdx.x == 0) {
        unsigned* bar = b.bar;
        __builtin_amdgcn_s_waitcnt(0);
        unsigned nloc = b.st[0], nx = b.st[1];
        if (nloc == 0u) { xcd_barrier_complete(bar, b.x, nloc, nx); b.st[0] = nloc; b.st[1] = nx; }
        const unsigned old = xb_add(&bar[XB_XSUB(b.x)], 1u);
        const unsigned gen = old / nloc;
        if (old + 1u == (gen + 1u) * nloc) {
            __builtin_amdgcn_fence(__ATOMIC_RELEASE, "agent");
            asm volatile("s_waitcnt vmcnt(0)" ::: "memory");
            const unsigned og = xb_add(&bar[XB_TOP], 1u);
            const unsigned tg = og / nx;
            if (og + 1u == (tg + 1u) * nx) xb_add(&bar[XB_TOPGEN], 1u);
            else XB_SPIN(xb_ld(&bar[XB_TOPGEN]) == tg, bar);
            __builtin_amdgcn_fence(__ATOMIC_ACQUIRE, "agent");
            xb_add(&bar[XB_XGEN(b.x)], 1u);
            asm volatile("s_waitcnt vmcnt(0)" ::: "memory");
        } else {
            XB_SPIN(xb_ld(&bar[XB_XGEN(b.x)]) == gen, bar);
            __builtin_amdgcn_fence(__ATOMIC_ACQUIRE, "agent");
            asm volatile("s_waitcnt vmcnt(0)" ::: "memory");
        }
    }
    __syncthreads();
}


__global__ void __launch_bounds__(NTHR, 2) hybrid_fwd(Params p0) {
    extern __shared__ __attribute__((aligned(16))) unsigned char shm_raw[];
    lds_t lds = (lds_t)shm_raw;
    cg::grid_group grid = cg::this_grid();
    volatile LAS unsigned* xst = (volatile LAS unsigned*)(lds + LDS_BYTES - 16);
    if (threadIdx.x == 0) { xst[0] = 0u; xst[1] = 0u; }
    __syncthreads();
    const XcdBarrier xb = xcd_barrier_post((unsigned*)(p0.ws + WS_BAR), xst);
    for (int pi = p0.ph_lo; pi < p0.ph_hi; ++pi) {
        if (pi > p0.ph_lo) { if (p0.ph_lo < 0) grid.sync();
            xcd_barrier(xb); }
        const int ph = p0.prog[pi] & 63; const bool dry = (p0.prog[pi] & 64) != 0; const int im = dry ? p0.dmask : 1023;
        Params p = p0;
        asm volatile("" : "+s"(p.ws), "+s"(p.out));
        u16* proj = (u16*)(p.ws + WS_PROJ);
        u16* retS = (u16*)(p.ws + WS_ST); u16* ssdS = retS + 16777216; u16* yh = retS;
        u16* WinT = (u16*)(p.ws + WS_WIN); u16* WoutT = (u16*)(p.ws + WS_WOUT); u16* memkv = (u16*)(p.ws + WS_MEMKV);
        const float* rc = (const float*)(p.ws + WS_ROPE); const float* rs = rc + SEQ * 64;
        float* dtraw = (float*)(p.ws + WS_DT); float* cdec = (float*)(p.ws + WS_CDEC);
        if (ph == 0) { if (PM & 1) phase_prep(lds, p); continue; }
        const int layer = (ph - 1) / 6, k = (ph - 1) % 6;
        if (k == 0 || k == 4 || (k == 2 && layer == 0 && !dry)) {
            const int njobs = (k == 2) ? 3 : 1;
            for (int j = (k == 2) ? 1 : 0; j < njobs; ++j) {
                pg8::Gemm g; int c = blockIdx.x;
                g.astream = 0; g.ostream = 0;
                if (k == 0) { g.A = yh; g.lda = 1024; g.Bt = WinT; g.ldb = 1024; g.M = T_TOK; g.N = NP; g.K = 1024; g.O = proj; g.ldc = NP; g.ostream = 1; }
                else if (k == 2) { const int l = j - 1; g.A = (const u16*)p.out + (size_t)l * 1048576; g.lda = 1024; g.Bt = (const u16*)p.out + 2097152 + (size_t)l * 1048576; g.ldb = 1024;
                    g.M = 1024; g.N = 1024; g.K = 1024; g.O = memkv + (size_t)l * 1048576; g.ldc = 1024; c = (int)((blockIdx.x + gridDim.x - 16u * l) % gridDim.x); }
                else { g.A = proj + (size_t)(C_RG >> 5) * STRM; g.lda = 32; g.astream = 1; g.Bt = WoutT; g.ldb = 2048; g.M = T_TOK; g.N = 1024; g.K = 2048; g.O = yh; g.ldc = 1024; }
                pg8::StaticOrder S; S.init(g.M, g.N, (int)gridDim.x, c);
                if (PM & 2) pg8::gemm_phase(lds, g, S);
            }
        } else if (k == 1) {
            const float* cw = p.conv_w + (size_t)layer * 4096; const float* cbias = p.conv_b + (size_t)layer * 1024;
            for (int it = blockIdx.x; it < 2560; it += gridDim.x) {
                if (it < 1024) { if (im & 4) sb_item(lds, proj, (it & ~63) | ((it + 16 * ((it >> 8) & 3)) & 63), dry); }
                else if (it < 2048) { const int i2 = it - 1024; if (im & 16) ret_state_item(lds, proj, retS, rc, rs, (i2 & ~(63 << 2)) | ((((i2 >> 2) + 16 * ((i2 >> 8) & 3)) & 63) << 2)); }
                else { const int i2 = it - 2048; if (im & 32) ssd_state_item(lds, proj, ssdS, cdec, dtraw, cw, cbias, p.dt_bias + layer * 8, p.a_log + layer * 8, (i2 & ~(63 << 1)) | ((((i2 >> 1) + 16 * ((i2 >> 8) & 1)) & 63) << 1)); }
            }
        }
        if (k == 2) {
            if ((PM & 64) && !dry) scan_phase(retS, ssdS, cdec, dry);
        } else if (k == 3) {
            const float* cw = p.conv_w + (size_t)layer * 4096; const float* cbias = p.conv_b + (size_t)layer * 1024;
            if (im & 8) mem_group(lds, proj, memkv + (size_t)layer * 1048576, dry);
            for (int it = blockIdx.x; it < 1536; it += gridDim.x) {
                if (it < 1024) { if (im & 128) ret_out_item(lds, proj, retS, rc, rs, (it & ~(63 << 2)) | ((((it >> 2) + 16 * ((it >> 8) & 3)) & 63) << 2), dry); }
                else { if (im & 256) ssd_out_item(lds, proj, ssdS, dtraw, cw, cbias, p.dt_bias + layer * 8, p.a_log + layer * 8, p.d_skip + layer * 8, p.ssd_norm_g + layer * 512, ((it - 1024) & ~(63 << 1)) | (((((it - 1024) >> 1) + 16 * (((it - 1024) >> 8) & 1)) & 63) << 1), dry); }
            }
        } else if (k == 5) {
            const bool has_next = layer == 0;
            if (has_next) { convert_win(lds, p.w_in + (size_t)1024 * DIN, WinT); convert_wout(lds, p.w_out + (size_t)2048 * 1024, WoutT); }
            if (PM & 512) row_pass(lds, layer == 0 ? p.x : p.out, p.out, yh, true, p.post_g + layer * 1024, has_next, p.pre_g + 1024, p.w_in + (size_t)1024 * DIN, dtraw, dry);
        }
    }
}


#ifdef DBG_STOP
__global__ void dbg_dump(Params p) {
    const u16* proj = (const u16*)(p.ws + WS_PROJ); const u16* st = (const u16*)(p.ws + WS_ST);
    const u16* mk = (const u16*)(p.ws + WS_MEMKV); const float* dt = (const float*)(p.ws + WS_DT); const float* cd = (const float*)(p.ws + WS_CDEC);
    const float* rp = (const float*)(p.ws + WS_ROPE);
    for (size_t i = (size_t)blockIdx.x * blockDim.x + threadIdx.x; i < (size_t)T_TOK * DM; i += (size_t)gridDim.x * blockDim.x) {
        float a = 0.f;
#if DBG_WHAT & 1
        for (int j = 0; j < 6; ++j) a += bf2f(proj[i * 6 + j]);
        a += bf2f(proj[201326592ull + (i >> 1)]);
#endif
#if DBG_WHAT & 2
        a += bf2f(st[i]);
#endif
#if DBG_WHAT & 4
        a += bf2f(mk[i & 2097151]) + dt[i & 262143] + cd[i & 2047] + rp[i & 1048575];
#endif
        p.out[i] = a;
    }
}
#endif

#ifdef DBG_STOP
constexpr int N_PHASES = DBG_STOP;
#else
constexpr int N_PHASES = 13;
#endif

extern "C" void kernel_launch(void* const* d_in, const int* in_sizes, int n_in, void* d_out, int out_size, void* d_ws, size_t ws_size, hipStream_t stream) {
    static int grid = 0;
    if (grid == 0) {
        if (n_in != 14 || in_sizes[0] != T_TOK * DM || out_size != T_TOK * DM || ws_size < WS_END) {
            fprintf(stderr, "kernel_launch: unexpected shapes (n_in %d, in0 %d, out %d, ws %zu need %zu)\n", n_in, n_in > 0 ? in_sizes[0] : -1, out_size, ws_size, (size_t)WS_END); grid = -1; return; }
        int dev = 0, cus = 0, per_cu = 0;
        hipGetDevice(&dev); hipDeviceGetAttribute(&cus, hipDeviceAttributeMultiprocessorCount, dev);
        if (hipFuncSetAttribute((const void*)hybrid_fwd, hipFuncAttributeMaxDynamicSharedMemorySize, LDS_BYTES) != hipSuccess) { fprintf(stderr, "kernel_launch: hipFuncSetAttribute failed\n"); grid = -1; return; }
        if (hipOccupancyMaxActiveBlocksPerMultiprocessor(&per_cu, (const void*)hybrid_fwd, NTHR, LDS_BYTES) != hipSuccess || per_cu < 1) per_cu = 1;
        (void)hipGetLastError();
        grid = cus * 1;
    }
    if (grid < 0) return;
    if (hipMemsetAsync((char*)d_ws + WS_BAR, 0, 16384, stream) != hipSuccess) { fprintf(stderr, "kernel_launch: memset failed\n"); return; }
    Params p{};
    p.x = (const float*)d_in[0]; p.mem = (const float*)d_in[1]; p.pre_g = (const float*)d_in[2]; p.post_g = (const float*)d_in[3]; p.w_in = (const float*)d_in[4];
    p.conv_w = (const float*)d_in[5]; p.conv_b = (const float*)d_in[6]; p.dt_bias = (const float*)d_in[7]; p.a_log = (const float*)d_in[8]; p.d_skip = (const float*)d_in[9];
    p.ssd_norm_g = (const float*)d_in[10]; p.mem_norm_g = (const float*)d_in[11]; p.w_mem_kv = (const float*)d_in[12]; p.w_out = (const float*)d_in[13];
    p.out = (float*)d_out; p.ws = (unsigned char*)d_ws;
    int np = 0;
#ifdef DMASK
    p.dmask = DMASK;
#else
    p.dmask = 1023;
#endif
    for (int ph = 0; ph < N_PHASES; ++ph) { p.prog[np++] = (unsigned char)ph;
#ifdef DUP_PHASE
        if (ph == DUP_PHASE) for (int d = 0; d < DUP_TIMES; ++d) p.prog[np++] = (unsigned char)(ph | 64);
#endif
    }
#if N_LAUNCH_MODE == 1
    p.ph_lo = 0; p.ph_hi = np;
    void* args[] = {&p};
    hipError_t e = hipLaunchCooperativeKernel((const void*)hybrid_fwd, dim3(grid), dim3(NTHR), args, LDS_BYTES, stream);
    if (e != hipSuccess) fprintf(stderr, "cooperative launch failed: %s (grid %d)\n", hipGetErrorString(e), grid);
#else
    for (int ph = 0; ph < np; ++ph) { p.ph_lo = ph; p.ph_hi = ph + 1; hipLaunchKernelGGL(hybrid_fwd, dim3(grid), dim3(NTHR), LDS_BYTES, stream, p); }
#ifdef DBG_STOP
    p.ph_lo = 0; p.ph_hi = 0; hipLaunchKernelGGL(dbg_dump, dim3(2048), dim3(256), 0, stream, p);
#endif
#endif
}
```

```cpp
#include <hip/hip_runtime.h>
#include <hip/hip_cooperative_groups.h>
#include <cstdio>
namespace cg = cooperative_groups;

#define LAS __attribute__((address_space(3)))
typedef unsigned short u16;
typedef short bf16x8 __attribute__((ext_vector_type(8)));
typedef short s16x4 __attribute__((ext_vector_type(4)));
typedef float f32x4 __attribute__((ext_vector_type(4)));
typedef unsigned u32x4 __attribute__((ext_vector_type(4)));
typedef unsigned u32x2 __attribute__((ext_vector_type(2)));
typedef LAS unsigned char* lds_t;

#ifndef N_LAUNCH_MODE
#define N_LAUNCH_MODE 1
#endif

constexpr int T_TOK = 32768, SEQ = 8192, DM = 1024, NP = 6656, DIN = 6664, NCHUNK = 64;
constexpr int C_RQ = 0, C_RK = 512, C_RV = 1024, C_XBC = 1536, C_SQ = 2560, C_SK = 3072, C_SV = 3584, C_MQ = 4096,
              C_RG = 4608, C_Z = 5120, C_SG = 5632, C_MG = 6144;
constexpr float EPS = 1e-6f;
constexpr int NTHR = 512;
#ifndef PM
#define PM 1023
#endif
constexpr int LDS_BYTES = 151552;

constexpr size_t WS_PROJ = 0;
constexpr size_t WS_ST = 436207616ull;
constexpr size_t WS_WIN = WS_ST + 67108864ull;
constexpr size_t WS_WOUT = WS_WIN + 13631488ull;
constexpr size_t WS_MEMKV = WS_WOUT + 4194304ull;
constexpr size_t WS_ROPE = WS_MEMKV + 4194304ull;
constexpr size_t WS_DT = WS_ROPE + 4194304ull;
constexpr size_t WS_CDEC = WS_DT + 1048576ull;
constexpr size_t WS_BAR = WS_CDEC + 8192ull;
constexpr size_t WS_END = WS_BAR + 16384ull;

constexpr size_t STRM = (size_t)T_TOK * 32;
__device__ __forceinline__ unsigned short* PJ(unsigned short* proj, size_t tok, int col) { return proj + (size_t)(col >> 5) * STRM + tok * 32 + (col & 31); }
__device__ __forceinline__ const unsigned short* PJ(const unsigned short* proj, size_t tok, int col) { return proj + (size_t)(col >> 5) * STRM + tok * 32 + (col & 31); }

struct Params {
    const float* x; const float* mem; const float* pre_g; const float* post_g; const float* w_in; const float* conv_w; const float* conv_b;
    const float* dt_bias; const float* a_log; const float* d_skip; const float* ssd_norm_g; const float* mem_norm_g; const float* w_mem_kv; const float* w_out;
    float* out; unsigned char* ws; int ph_lo, ph_hi; unsigned char prog[32]; int dmask, pad_;
};

typedef __bf16 bf16x2_t __attribute__((ext_vector_type(2)));
typedef float f32x2_t __attribute__((ext_vector_type(2)));
__device__ __forceinline__ unsigned pk2(float lo, float hi) { const f32x2_t v = {lo, hi}; const bf16x2_t b = __builtin_convertvector(v, bf16x2_t); return __builtin_bit_cast(unsigned, b); }
__device__ __forceinline__ u16 f2bf(float f) { return (u16)(pk2(f, 0.f) & 0xffffu); }
__device__ __forceinline__ float bf2f(u16 b) { return __uint_as_float(((unsigned)b) << 16); }
__device__ __forceinline__ float bflo(unsigned w) { return __uint_as_float(w << 16); }
__device__ __forceinline__ float bfhi(unsigned w) { return __uint_as_float(w & 0xffff0000u); }
__device__ __forceinline__ float siluf(float v) { return v / (1.f + __expf(-v)); }
__device__ __forceinline__ float softplusf(float x) { return fmaxf(x, 0.f) + log1pf(__expf(-fabsf(x))); }
__device__ __forceinline__ int otid() { int t = __builtin_amdgcn_workitem_id_x(); asm volatile("" : "+v"(t)); return t; }
#define MFMA16(a, b, c) __builtin_amdgcn_mfma_f32_16x16x32_bf16(a, b, c, 0, 0, 0)

__device__ __forceinline__ bf16x8 frag_row(lds_t base, int ld, int i0, int k0, int fr, int fq) {
    return *(const LAS bf16x8*)(base + ((i0 + fr) * ld + k0 + fq * 8) * 2);
}
__device__ __forceinline__ s16x4 trrd(lds_t p) { return __builtin_bit_cast(s16x4, __builtin_amdgcn_ds_read_tr16_b64_v4i16((LAS s16x4*)p)); }
__device__ __forceinline__ bf16x8 frag_tr(lds_t base, int ld, int i0, int k0, int fr, int fq) {
    lds_t p = base + ((k0 + 8 * fq + (fr >> 2)) * ld + i0 + 4 * (fr & 3)) * 2;
    const s16x4 lo = trrd(p), hi = trrd(p + 8 * ld);
    return (bf16x8){lo[0], lo[1], lo[2], lo[3], hi[0], hi[1], hi[2], hi[3]};
}
__device__ __forceinline__ void copy_tile(lds_t dst, int ldd, const u16* src, size_t lds_, int rows, int cpr_shift) {
    const int n = rows << cpr_shift;
#pragma unroll
    for (int i = otid(); i < n; i += NTHR) { const int r = i >> cpr_shift, ch = i & ((1 << cpr_shift) - 1);
        const u32x4 v = *(const u32x4*)(src + (size_t)r * lds_ + ch * 8);
        *(LAS u32x4*)(dst + (r * ldd + ch * 8) * 2) = v; }
}
__device__ __forceinline__ void copy_tile_pj(lds_t dst, int ldd, const unsigned short* proj, size_t tok0, int col) {
#pragma unroll
    for (int i = otid(); i < 2048; i += NTHR) { const int r = (i >> 2) & 127, ch = ((i >> 9) << 2) | (i & 3);
        const u32x4 v = *(const u32x4*)PJ(proj, tok0 + r, col + ch * 8);
        *(LAS u32x4*)(dst + (r * ldd + ch * 8) * 2) = v; }
}
__device__ __forceinline__ void rope_tile(lds_t dst, const u16* proj, size_t tok0, int col, const float* rc, const float* rs, int pos0, float bscale, float zl2) {
#pragma unroll
    for (int i = otid(); i < 1024; i += NTHR) { const int m = (i >> 2) & 127, ch = ((i >> 9) << 2) | (i & 3);
        const u32x4 a = *(const u32x4*)PJ(proj, tok0 + m, col + ch * 8), b = *(const u32x4*)PJ(proj, tok0 + m, col + 64 + ch * 8);
        const float* cp = rc + (size_t)(pos0 + m) * 64 + ch * 8; const float* sp = rs + (size_t)(pos0 + m) * 64 + ch * 8;
        const f32x4 c0 = *(const f32x4*)cp, c1 = *(const f32x4*)(cp + 4), s0 = *(const f32x4*)sp, s1 = *(const f32x4*)(sp + 4);
        const float sc = bscale * exp2f(zl2 * (float)(127 - m));
        float t1[8], t2[8], cc[8], ss[8], o1[8], o2[8];
#pragma unroll
        for (int e = 0; e < 4; ++e) { t1[2 * e] = bflo(a[e]); t1[2 * e + 1] = bfhi(a[e]); t2[2 * e] = bflo(b[e]); t2[2 * e + 1] = bfhi(b[e]);
            cc[e] = c0[e]; cc[e + 4] = c1[e]; ss[e] = s0[e]; ss[e + 4] = s1[e]; }
#pragma unroll
        for (int e = 0; e < 8; ++e) { o1[e] = (t1[e] * cc[e] - t2[e] * ss[e]) * sc; o2[e] = (t2[e] * cc[e] + t1[e] * ss[e]) * sc; }
        u32x4 w1, w2;
#pragma unroll
        for (int e = 0; e < 4; ++e) { w1[e] = pk2(o1[2 * e], o1[2 * e + 1]); w2[e] = pk2(o2[2 * e], o2[2 * e + 1]); }
        *(LAS u32x4*)(dst + (m * 136 + ch * 8) * 2) = w1; *(LAS u32x4*)(dst + (m * 136 + 64 + ch * 8) * 2) = w2; }
}
template <int NCH, bool SCALE>
__device__ __forceinline__ void conv_tile(lds_t dst, int ldd, const u16* proj, size_t tok0, int pos0, int ch0, const float* cw, const float* cb, lds_t scl) {
    constexpr int TPC = NTHR / NCH, RPT = 128 / TPC;
    const int t = otid(), chunk = t % NCH, rs0 = (t / NCH) * RPT, ch = ch0 + chunk * 8;
    float w[4][8], bias[8];
#pragma unroll
    for (int j = 0; j < 4; ++j) { const f32x4 a = *(const f32x4*)(cw + j * 1024 + ch), b = *(const f32x4*)(cw + j * 1024 + ch + 4);
#pragma unroll
        for (int e = 0; e < 4; ++e) { w[j][e] = a[e]; w[j][e + 4] = b[e]; } }
    { const f32x4 a = *(const f32x4*)(cb + ch), b = *(const f32x4*)(cb + ch + 4);
#pragma unroll
      for (int e = 0; e < 4; ++e) { bias[e] = a[e]; bias[e + 4] = b[e]; } }
    u32x4 x[RPT + 3];
#pragma unroll
    for (int i = 0; i < RPT + 3; ++i) { const int rr = rs0 - 3 + i; x[i] = (u32x4){0u, 0u, 0u, 0u};
        if (pos0 + rr >= 0) x[i] = *(const u32x4*)PJ(proj, tok0 + rr, C_XBC + ch); }
#pragma unroll
    for (int i = 0; i < RPT; ++i) { const int r = rs0 + i;
        float acc[8];
#pragma unroll
        for (int e = 0; e < 8; ++e) acc[e] = bias[e];
#pragma unroll
        for (int j = 0; j < 4; ++j) { const u32x4 v = x[i + j];
#pragma unroll
            for (int e = 0; e < 4; ++e) { acc[2 * e] += w[j][2 * e] * bflo(v[e]); acc[2 * e + 1] += w[j][2 * e + 1] * bfhi(v[e]); } }
        float sc = 1.f;
        if (SCALE) sc = *(const LAS float*)(scl + (r * 4 + (chunk >> 3)) * 4);
        u32x4 o;
#pragma unroll
        for (int e = 0; e < 4; ++e) o[e] = pk2(siluf(acc[2 * e]) * sc, siluf(acc[2 * e + 1]) * sc);
        *(LAS u32x4*)(dst + (r * ldd + chunk * 8) * 2) = o;
    }
}

namespace pg8 {
constexpr int BM = 256, BK = 64, HALF = 128, HTB = HALF * BK * 2, STAGE_BYTES = 8 * HTB, NXCD = 8, WGM = 8;
__device__ __forceinline__ int lds_byte(int r, int c) { const int st = (r >> 4) * 2 + (c >> 5), rr = r & 15, cc = c & 31, ob = rr * 64 + cc * 2; return st * 1024 + (ob ^ (((ob >> 9) & 1) << 5)); }
__device__ __forceinline__ void stage_rc(int b, int& R, int& C) { const int st = b / 1024, sb = b % 1024, swz = sb ^ (((sb >> 9) & 1) << 5); R = (st >> 1) * 16 + swz / 64; C = (st & 1) * 32 + (swz % 64) / 2; }
__device__ __forceinline__ int perm32(int rho) { const int n = rho >> 4, i = rho & 15; return 8 * (i >> 2) + 4 * n + (i & 3); }
struct Unit { int pm, pn; };
struct Gemm { const u16* A; const u16* Bt; int M, N, K, lda, ldb; u16* O; int ldc; int astream, ostream; };
struct StaticOrder {
    int nM, nN, nwg, G, c;
    __device__ void init(int M, int N, int G_, int c_) { nM = M / BM; nN = N / BM; nwg = nM * nN; G = G_; c = c_; }
    __device__ bool next(int i, Unit& u) const {
        const long L = (long)i * G + c; if (L >= nwg) return false;
        int wgid = (int)L; { const int q = nwg / NXCD, r = nwg % NXCD, xcd = wgid % NXCD, off = wgid / NXCD; wgid = (xcd < r ? xcd * (q + 1) : r * (q + 1) + (xcd - r) * q) + off; }
        const int nig = WGM * nN, gid = wgid / nig, fm = gid * WGM, gsz = (nM - fm) < WGM ? (nM - fm) : WGM;
        u.pm = fm + ((wgid % nig) % gsz); u.pn = (wgid % nig) / gsz; return true;
    }
};
__device__ __forceinline__ void epi_bf16(const Gemm& g, const f32x4 (&acc)[2][2][4][2], const Unit& u, int wr, int wc, int fr, int fq) {
    const int row0 = u.pm * BM + wr * 64 + fr, col0 = u.pn * BM + wc * 32 + 8 * fq;
#pragma unroll
    for (int ai = 0; ai < 2; ++ai)
#pragma unroll
        for (int m = 0; m < 4; ++m) { const size_t row = (size_t)(row0 + ai * HALF + m * 16);
            u16* rowp = g.ostream ? g.O + (size_t)(8 * u.pn + wc) * STRM + row * 32 + 8 * fq : g.O + row * g.ldc + col0;
            const size_t bstep = g.ostream ? 4 * STRM : (size_t)HALF;
#pragma unroll
            for (int bj = 0; bj < 2; ++bj) { const f32x4 v0 = acc[ai][bj][m][0], v1 = acc[ai][bj][m][1];
                u32x4 w; w.x = pk2(v0[0], v0[1]); w.y = pk2(v0[2], v0[3]); w.z = pk2(v1[0], v1[1]); w.w = pk2(v1[2], v1[3]);
                *(u32x4*)(rowp + bj * bstep) = w; } }
}
__device__ __forceinline__ void gemm_phase(lds_t lds, const Gemm g, const StaticOrder& S) {
    const int tid = otid(), wid = __builtin_amdgcn_readfirstlane(tid >> 6), lane = tid & 63, wr = wid >> 2, wc = wid & 3, fr = lane & 15, fq = lane >> 4;
    const int K = g.K, nt = K / BK;
    unsigned voffA[2], voffB[2];
#pragma unroll
    for (int i = 0; i < 2; ++i) { int R, C; stage_rc(tid * 16 + i * 8192, R, C); const int Rb = (R & ~31) + perm32(R & 31);
        voffA[i] = g.astream ? (unsigned)((size_t)(C >> 5) * STRM + R * 32 + (C & 31)) * 2u : (unsigned)(R * g.lda + C) * 2u; voffB[i] = (unsigned)(Rb * g.ldb + C) * 2u; }
    const size_t kstep = (size_t)(BK * 2);
    const bool astr = g.astream != 0;
#define PG8_KOFFA(t) (astr ? (size_t)(t) * (STRM * 4) : (size_t)(t) * 128)
    const size_t hstepA = (size_t)HALF * g.lda * 2, hstepB = (size_t)HALF * g.ldb * 2;
    const size_t tstepA = 2 * hstepA, tstepB = 2 * hstepB;
    const unsigned ldsw = (unsigned)wid * 1024u;
    const int aoff = lds_byte(wr * 64 + fr, fq * 8), boff = lds_byte(wc * 32 + fr, fq * 8);
#define PG8_SA(b, h) (((b) * 2 + (h)) * HTB)
#define PG8_SB(b, h) ((4 + (b) * 2 + (h)) * HTB)
#define PG8_STAGE(bufoff, gbase, voff) do { _Pragma("unroll") for (int _i = 0; _i < 2; ++_i) \
        __builtin_amdgcn_global_load_lds((const unsigned*)((const char*)(gbase) + (voff)[_i]), (LAS unsigned*)(lds + (bufoff) + ldsw + _i * 8192), 16, 0, 0); } while (0)
#define PG8_LDA(dst, b, h) do { _Pragma("unroll") for (int m = 0; m < 4; ++m) _Pragma("unroll") for (int k = 0; k < 2; ++k) dst[m][k] = *(const LAS bf16x8*)(lds + PG8_SA(b, h) + aoff + m * 2048 + k * 1024); } while (0)
#define PG8_LDB(dst, b, h) do { _Pragma("unroll") for (int n = 0; n < 2; ++n) _Pragma("unroll") for (int k = 0; k < 2; ++k) dst[n][k] = *(const LAS bf16x8*)(lds + PG8_SB(b, h) + boff + n * 2048 + k * 1024); } while (0)
#define PG8_MMA(ai, bj, At, Bt) do { __builtin_amdgcn_s_setprio(1); _Pragma("unroll") for (int m = 0; m < 4; ++m) _Pragma("unroll") for (int n = 0; n < 2; ++n) _Pragma("unroll") for (int k = 0; k < 2; ++k) \
        acc[ai][bj][m][n] = __builtin_amdgcn_mfma_f32_16x16x32_bf16(Bt[n][k], At[m][k], acc[ai][bj][m][n], 0, 0, 0); __builtin_amdgcn_s_setprio(0); } while (0)
#define PG8_WAIT_V(n) asm volatile("s_waitcnt vmcnt(" #n ")" ::: "memory")
#define PG8_WAIT_L(n) asm volatile("s_waitcnt lgkmcnt(" #n ")" ::: "memory")
#define PG8_BAR __builtin_amdgcn_s_barrier()
#define PG8_SCHED __builtin_amdgcn_sched_barrier(0)
    Unit cur, nxt; int ui = 0;
    if (!S.next(0, cur)) return;
    f32x4 acc[2][2][4][2];
#pragma unroll
    for (int a = 0; a < 2; ++a)
#pragma unroll
        for (int b = 0; b < 2; ++b)
#pragma unroll
            for (int m = 0; m < 4; ++m)
#pragma unroll
                for (int n = 0; n < 2; ++n) acc[a][b][m][n] = (f32x4){0.f, 0.f, 0.f, 0.f};
    bf16x8 At[4][2], B0[2][2], B1[2][2];
    const char* cA = (const char*)g.A + (size_t)cur.pm * tstepA; const char* cB = (const char*)g.Bt + (size_t)cur.pn * tstepB;
    PG8_STAGE(PG8_SB(0, 0), cB, voffB); PG8_STAGE(PG8_SA(0, 0), cA, voffA); PG8_STAGE(PG8_SB(0, 1), cB + hstepB, voffB); PG8_STAGE(PG8_SA(0, 1), cA + hstepA, voffA);
    if (wr == 1) PG8_BAR;
    PG8_WAIT_V(4); PG8_BAR;
    PG8_STAGE(PG8_SB(1, 0), cB + kstep, voffB); PG8_STAGE(PG8_SA(1, 0), cA + PG8_KOFFA(1), voffA); PG8_STAGE(PG8_SB(1, 1), cB + hstepB + kstep, voffB);
    PG8_WAIT_V(6); PG8_BAR;
    for (;;) {
        const bool has_next = S.next(ui + 1, nxt);
        const char* nA = has_next ? (const char*)g.A + (size_t)nxt.pm * tstepA : cA; const char* nB = has_next ? (const char*)g.Bt + (size_t)nxt.pn * tstepB : cB;
        for (int t = 0; t < nt; t += 2) {
            const bool last = (t == nt - 2);
            const char* a1 = cA + PG8_KOFFA(t + 1);
            const char* a2 = last ? nA : cA + PG8_KOFFA(t + 2); const char* b2 = last ? nB : cB + (size_t)(t + 2) * kstep;
            const char* a3 = last ? nA + PG8_KOFFA(1) : cA + PG8_KOFFA(t + 3); const char* b3 = b2 + kstep;
            PG8_LDB(B0, 0, 0); PG8_SCHED; PG8_LDA(At, 0, 0); PG8_STAGE(PG8_SA(1, 1), a1 + hstepA, voffA);
            PG8_WAIT_L(8); PG8_BAR; PG8_WAIT_L(0); PG8_MMA(0, 0, At, B0); PG8_BAR; PG8_SCHED;
            PG8_LDB(B1, 0, 1); PG8_STAGE(PG8_SB(0, 0), b2, voffB);
            PG8_BAR; PG8_WAIT_L(0); PG8_MMA(0, 1, At, B1); PG8_BAR;
            PG8_LDA(At, 0, 1); PG8_STAGE(PG8_SA(0, 0), a2, voffA);
            PG8_BAR; PG8_WAIT_L(0); PG8_MMA(1, 0, At, B0); PG8_BAR; PG8_SCHED;
            PG8_STAGE(PG8_SB(0, 1), b2 + hstepB, voffB);
            PG8_WAIT_V(6); PG8_BAR; PG8_MMA(1, 1, At, B1); PG8_BAR;
            PG8_LDB(B0, 1, 0); PG8_SCHED; PG8_LDA(At, 1, 0); PG8_STAGE(PG8_SA(0, 1), a2 + hstepA, voffA);
            PG8_WAIT_L(8); PG8_BAR; PG8_WAIT_L(0); PG8_MMA(0, 0, At, B0); PG8_BAR; PG8_SCHED;
            PG8_LDB(B1, 1, 1); PG8_STAGE(PG8_SB(1, 0), b3, voffB);
            PG8_BAR; PG8_WAIT_L(0); PG8_MMA(0, 1, At, B1); PG8_BAR;
            PG8_LDA(At, 1, 1); PG8_STAGE(PG8_SA(1, 0), a3, voffA);
            PG8_BAR; PG8_WAIT_L(0); PG8_MMA(1, 0, At, B0); PG8_BAR; PG8_SCHED;
            PG8_STAGE(PG8_SB(1, 1), b3 + hstepB, voffB);
            PG8_WAIT_V(6); PG8_BAR; PG8_MMA(1, 1, At, B1); PG8_BAR;
        }
        epi_bf16(g, acc, cur, wr, wc, fr, fq);
        if (!has_next) break;
#pragma unroll
        for (int a = 0; a < 2; ++a)
#pragma unroll
            for (int b = 0; b < 2; ++b)
#pragma unroll
                for (int m = 0; m < 4; ++m)
#pragma unroll
                    for (int n = 0; n < 2; ++n) acc[a][b][m][n] = (f32x4){0.f, 0.f, 0.f, 0.f};
        cur = nxt; cA = nA; cB = nB; ++ui;
    }
    PG8_WAIT_V(0);
    if (wr == 0) PG8_BAR;
    PG8_BAR;
#undef PG8_KOFFA
#undef PG8_SA
#undef PG8_SB
#undef PG8_STAGE
#undef PG8_LDA
#undef PG8_LDB
#undef PG8_MMA
#undef PG8_WAIT_V
#undef PG8_WAIT_L
#undef PG8_BAR
#undef PG8_SCHED
}
}

__device__ __forceinline__ int win_srccol(int seg) {
    switch (seg) { case 0: return 0; case 1: return 512; case 2: return 1024; case 3: return 2048; case 4: return 2560; case 5: return 3592; case 6: return 4104;
                   case 7: return 4616; case 8: return 5640; case 9: return 1536; case 10: return 3072; case 11: return 5128; default: return 6152; }
}
__device__ __forceinline__ void wt_tile(lds_t lds, const float* src, int src_ld, int scol0, u16* dst, int K, int k0, int n0) {
    const int c = otid() & 63, r8 = otid() >> 6;
#pragma unroll
    for (int i = 0; i < 8; ++i) { const int r = r8 + 8 * i; *(LAS float*)(lds + (r * 65 + c) * 4) = src[(size_t)(k0 + r) * src_ld + scol0 + c]; }
    __syncthreads();
#pragma unroll
    for (int i = 0; i < 8; ++i) { const int nn = r8 + 8 * i; dst[(size_t)(n0 + nn) * K + k0 + c] = f2bf(*(const LAS float*)(lds + (c * 65 + nn) * 4)); }
    __syncthreads();
}
template <bool WIN>
__device__ __forceinline__ void convert_mat(lds_t lds, const float* src, int src_ld, u16* dst, int K, int kshift  , int nunits) {
    const int c = otid() & 63, r8 = otid() >> 6, G = gridDim.x;
    for (int u0 = blockIdx.x; u0 < nunits; u0 += 4 * G) {
        float v[4][8];
#pragma unroll
        for (int q = 0; q < 4; ++q) { const int u = u0 + q * G; const bool ok = u < nunits; const int uu = ok ? u : u0;
            const int kt = uu & ((1 << kshift) - 1), n0 = (uu >> kshift) * 64, k0 = kt * 64;
            const int sc = WIN ? (win_srccol(n0 >> 9) + (n0 & 511)) : n0;
#pragma unroll
            for (int i = 0; i < 8; ++i) v[q][i] = src[(size_t)(k0 + r8 + 8 * i) * src_ld + sc + c]; }
#pragma unroll
        for (int q = 0; q < 4; ++q)
#pragma unroll
            for (int i = 0; i < 8; ++i) *(LAS float*)(lds + q * 16640 + ((r8 + 8 * i) * 65 + c) * 4) = v[q][i];
        __syncthreads();
#pragma unroll
        for (int q = 0; q < 4; ++q) { const int u = u0 + q * G; if (u < nunits) { const int kt = u & ((1 << kshift) - 1), n0 = (u >> kshift) * 64, k0 = kt * 64;
#pragma unroll
            for (int i = 0; i < 8; ++i) { const int nn = r8 + 8 * i; dst[(size_t)(n0 + nn) * K + k0 + c] = f2bf(*(const LAS float*)(lds + q * 16640 + (c * 65 + nn) * 4)); } } }
        __syncthreads();
    }
}
__device__ __forceinline__ void convert_win(lds_t lds, const float* w_in_l, u16* WinT) { convert_mat<true>(lds, w_in_l, DIN, WinT, 1024, 4, 16 * 104); }
__device__ __forceinline__ void convert_wout(lds_t lds, const float* w_out_l, u16* WoutT) { convert_mat<false>(lds, w_out_l, 1024, WoutT, 2048, 5, 32 * 16); }
__device__ __forceinline__ float wave_sum(float v) {
#pragma unroll
    for (int m = 32; m >= 1; m >>= 1) v += __shfl_xor(v, m);
    return v;
}
__device__ __forceinline__ void row_pass(lds_t lds, const float* xin, float* xout, u16* yh, bool has_y, const float* post_g, bool has_next, const float* pre_g, const float* w_in_next, float* dtraw, bool dry) {
    const int tid = otid(), wid = tid >> 6, lane = tid & 63;
    if (has_next) { for (int i = tid; i < 8192; i += NTHR) { const int k = i >> 3, j = i & 7; *(LAS float*)(lds + (j * 1024 + k) * 4) = w_in_next[(size_t)k * DIN + 3584 + j]; } }
    __syncthreads();
    const int stride = gridDim.x * 8;
    int row = blockIdx.x * 8 + wid;
    f32x4 nx[4]; u32x2 ny[4];
#pragma unroll
    for (int i = 0; i < 4; ++i) { nx[i] = (f32x4){0.f, 0.f, 0.f, 0.f}; ny[i] = (u32x2){0u, 0u}; }
    if (row < T_TOK) {
#pragma unroll
        for (int i = 0; i < 4; ++i) { nx[i] = *(const f32x4*)(xin + (size_t)row * DM + i * 256 + lane * 4); if (has_y) ny[i] = *(const u32x2*)(yh + (size_t)row * DM + i * 256 + lane * 4); } }
    for (; row < T_TOK; row += stride) {
        f32x4 xv[4]; u32x2 yw[4];
#pragma unroll
        for (int i = 0; i < 4; ++i) { xv[i] = nx[i]; yw[i] = ny[i]; }
        const int nrow = row + stride;
        if (nrow < T_TOK) {
#pragma unroll
            for (int i = 0; i < 4; ++i) { nx[i] = *(const f32x4*)(xin + (size_t)nrow * DM + i * 256 + lane * 4); if (has_y) ny[i] = *(const u32x2*)(yh + (size_t)nrow * DM + i * 256 + lane * 4); } }
        if (has_y) {
            f32x4 yv[4]; float ss = 0.f;
#pragma unroll
            for (int i = 0; i < 4; ++i) { yv[i] = (f32x4){bflo(yw[i][0]), bfhi(yw[i][0]), bflo(yw[i][1]), bfhi(yw[i][1])}; ss += yv[i][0] * yv[i][0] + yv[i][1] * yv[i][1] + yv[i][2] * yv[i][2] + yv[i][3] * yv[i][3]; }
            ss = wave_sum(ss); const float r1 = rsqrtf(ss * (1.f / 1024.f) + EPS);
#pragma unroll
            for (int i = 0; i < 4; ++i) { const f32x4 g = *(const f32x4*)(post_g + i * 256 + lane * 4); xv[i] += yv[i] * r1 * g; if (!dry) *(f32x4*)(xout + (size_t)row * DM + i * 256 + lane * 4) = xv[i]; }
        }
        if (has_next) {
            float ss = 0.f;
#pragma unroll
            for (int i = 0; i < 4; ++i) ss += xv[i][0] * xv[i][0] + xv[i][1] * xv[i][1] + xv[i][2] * xv[i][2] + xv[i][3] * xv[i][3];
            ss = wave_sum(ss); const float r2 = rsqrtf(ss * (1.f / 1024.f) + EPS);
            float d[8];
#pragma unroll
            for (int j = 0; j < 8; ++j) d[j] = 0.f;
#pragma unroll
            for (int i = 0; i < 4; ++i) { const f32x4 g = *(const f32x4*)(pre_g + i * 256 + lane * 4); const f32x4 h = xv[i] * r2 * g;
                u32x2 w; w[0] = pk2(h[0], h[1]); w[1] = pk2(h[2], h[3]); if (!dry) *(u32x2*)(yh + (size_t)row * DM + i * 256 + lane * 4) = w;
#pragma unroll
                for (int j = 0; j < 8; ++j) { const f32x4 wv = *(const LAS f32x4*)(lds + (j * 1024 + i * 256 + lane * 4) * 4); d[j] += h[0] * wv[0] + h[1] * wv[1] + h[2] * wv[2] + h[3] * wv[3]; } }
            const bool b5 = (lane & 32) != 0, b4 = (lane & 16) != 0, b3 = (lane & 8) != 0;
            float e[4], f[2];
#pragma unroll
            for (int j = 0; j < 4; ++j) { const float snd = b5 ? d[j] : d[j + 4], kp = b5 ? d[j + 4] : d[j]; e[j] = kp + __shfl_xor(snd, 32); }
#pragma unroll
            for (int j = 0; j < 2; ++j) { const float snd = b4 ? e[j] : e[j + 2], kp = b4 ? e[j + 2] : e[j]; f[j] = kp + __shfl_xor(snd, 16); }
            float gsum; { const float snd = b3 ? f[0] : f[1], kp = b3 ? f[1] : f[0]; gsum = kp + __shfl_xor(snd, 8); }
            gsum += __shfl_xor(gsum, 4); gsum += __shfl_xor(gsum, 2); gsum += __shfl_xor(gsum, 1);
            if ((lane & 7) == 0 && !dry) dtraw[(size_t)row * 8 + (b5 ? 4 : 0) + (b4 ? 2 : 0) + (b3 ? 1 : 0)] = gsum;
        }
    }
    __syncthreads();
}

__device__ __forceinline__ void phase_prep(lds_t lds, const Params& p) {
    u16* WinT = (u16*)(p.ws + WS_WIN); u16* WoutT = (u16*)(p.ws + WS_WOUT);
    u16* memn = (u16*)p.out; u16* WkvT = (u16*)p.out + 2 * 1024 * 1024;
    float* rc = (float*)(p.ws + WS_ROPE); float* rs = rc + SEQ * 64;
    convert_win(lds, p.w_in, WinT);
    convert_wout(lds, p.w_out, WoutT);
    convert_mat<false>(lds, p.w_mem_kv, 1024, WkvT, 1024, 4, 256);
    convert_mat<false>(lds, p.w_mem_kv + (size_t)1024 * 1024, 1024, WkvT + (size_t)1024 * 1024, 1024, 4, 256);
    for (int i = blockIdx.x * NTHR + otid(); i < SEQ * 64; i += gridDim.x * NTHR) { const int pos = i >> 6, f = i & 63;
        const float inv = exp2f(-(float)f * 0.20762050593046015f);
        const float ang = (float)pos * inv;
        const float kq = rintf(ang * 0.15915494309189535f);
        float rf = fmaf(-kq, 6.2831854820251465f, ang); rf = fmaf(-kq, -1.7484555e-7f, rf);
        rc[i] = __cosf(rf); rs[i] = __sinf(rf); }
    { const int wid = otid() >> 6, lane = otid() & 63;
      for (int row = blockIdx.x * 8 + wid; row < 2048; row += gridDim.x * 8) { const int l = row >> 10, r = row & 1023;
          f32x4 xv[4]; float ss = 0.f;
#pragma unroll
          for (int i = 0; i < 4; ++i) { xv[i] = *(const f32x4*)(p.mem + (size_t)r * DM + i * 256 + lane * 4); ss += xv[i][0] * xv[i][0] + xv[i][1] * xv[i][1] + xv[i][2] * xv[i][2] + xv[i][3] * xv[i][3]; }
          ss = wave_sum(ss); const float r2 = rsqrtf(ss * (1.f / 1024.f) + EPS);
#pragma unroll
          for (int i = 0; i < 4; ++i) { const f32x4 g = *(const f32x4*)(p.mem_norm_g + l * 1024 + i * 256 + lane * 4); const f32x4 h = xv[i] * r2 * g;
              u32x2 w; w[0] = pk2(h[0], h[1]); w[1] = pk2(h[2], h[3]); *(u32x2*)(memn + (size_t)row * DM + i * 256 + lane * 4) = w; } } }
    row_pass(lds, p.x, nullptr, (u16*)(p.ws + WS_ST), false, nullptr, true, p.pre_g, p.w_in, (float*)(p.ws + WS_DT), false);
}

__device__ __forceinline__ float ret_log2g(int h) { return log2f(1.f - exp2f(-5.f - (float)h)); }

__device__ __forceinline__ bf16x8 pack8(const f32x4& a, const f32x4& b) {
    u32x4 w; w[0] = pk2(a[0], a[1]); w[1] = pk2(a[2], a[3]); w[2] = pk2(b[0], b[1]); w[3] = pk2(b[2], b[3]); return __builtin_bit_cast(bf16x8, w);
}
__device__ __forceinline__ bf16x8 frag_vtl(lds_t base, int ld, int e0, int k2, int fr, int fq) {
    lds_t p = base + ((32 * k2 + 4 * fq + (fr >> 2)) * ld + e0 + 4 * (fr & 3)) * 2;
    const s16x4 lo = trrd(p), hi = trrd(p + 16 * ld * 2);
    return (bf16x8){lo[0], lo[1], lo[2], lo[3], hi[0], hi[1], hi[2], hi[3]};
}
__device__ __forceinline__ bf16x8 frag_vt(lds_t base, int e0, int k2, int fr, int fq) {
    lds_t p = base + ((32 * k2 + 4 * fq + (fr >> 2)) * 136 + e0 + 4 * (fr & 3)) * 2;
    const s16x4 lo = trrd(p), hi = trrd(p + 16 * 136 * 2);
    return (bf16x8){lo[0], lo[1], lo[2], lo[3], hi[0], hi[1], hi[2], hi[3]};
}
__device__ __forceinline__ void sb_item(lds_t lds, u16* proj, int it, bool dry) {
    const int tid = otid(), wid = tid >> 6, lane = tid & 63, fr = lane & 15, fq = lane >> 4;
    const int qb = it & 63, h = (it >> 6) & 3, b = it >> 8;
    const size_t tok0 = (size_t)b * SEQ + qb * 128;
    lds_t Ks = lds, Vs = lds + 17408, red = lds + 35840;
    const int tpos = qb * 128 + 16 * wid + fr;
    bf16x8 qf[4];
    {
#pragma unroll
      for (int ks = 0; ks < 4; ++ks) qf[ks] = __builtin_bit_cast(bf16x8, *(const u32x4*)PJ(proj, tok0 + 16 * wid + fr, C_SQ + h * 128 + 8 * fq + 32 * ks)); }
    const int sr = (tid >> 2) & 31, sc = ((tid >> 7) << 2) | (tid & 3);
    u32x4 kr0, kr1, vr0, vr1;
    { const size_t t0 = (size_t)b * SEQ + (2 * qb + 1) * 64 + sr; const u16* kp = PJ(proj, t0, C_SK + h * 128 + sc * 8); const size_t vo = (size_t)((C_SV - C_SK) >> 5) * STRM;
      kr0 = *(const u32x4*)(kp); kr1 = *(const u32x4*)(kp + 32 * 32); vr0 = *(const u32x4*)(kp + vo); vr1 = *(const u32x4*)(kp + vo + 32 * 32); }
    __syncthreads();
    *(LAS u32x4*)(Ks + (sr * 136 + sc * 8) * 2) = kr0; *(LAS u32x4*)(Ks + ((sr + 32) * 136 + sc * 8) * 2) = kr1;
    *(LAS u32x4*)(Vs + (sr * 144 + sc * 8) * 2) = vr0; *(LAS u32x4*)(Vs + ((sr + 32) * 144 + sc * 8) * 2) = vr1;
    __syncthreads();
    f32x4 O[8], carry = (f32x4){0.f, 0.f, 0.f, 0.f};
#pragma unroll
    for (int n = 0; n < 8; ++n) O[n] = (f32x4){0.f, 0.f, 0.f, 0.f};
    const bf16x8 ones = (bf16x8){0x3F80, 0x3F80, 0x3F80, 0x3F80, 0x3F80, 0x3F80, 0x3F80, 0x3F80};
    bf16x8 U00, U10;
#pragma unroll
    for (int jj = 0; jj < 8; ++jj) { const int j = (jj < 4 ? 4 * fq + jj : 16 + 4 * fq + jj - 4); U00[jj] = (j > fr) ? (short)0x3F80 : (short)0; U10[jj] = (j > 16 + fr) ? (short)0x3F80 : (short)0; }
    float wmax = 0.f;
    for (int kb = 2 * qb + 1; kb >= 0; --kb) {
        if (kb > 0) { const size_t t0 = (size_t)b * SEQ + (kb - 1) * 64 + sr; const u16* kp = PJ(proj, t0, C_SK + h * 128 + sc * 8); const size_t vo = (size_t)((C_SV - C_SK) >> 5) * STRM;
            kr0 = *(const u32x4*)(kp); kr1 = *(const u32x4*)(kp + 32 * 32); vr0 = *(const u32x4*)(kp + vo); vr1 = *(const u32x4*)(kp + vo + 32 * 32); }
        const bool active = (kb * 64 < qb * 128 + 16 * wid + 15) && !(wmax < -110.f);
        if (active) {
        f32x4 S[4];
        { bf16x8 kf[16];
#pragma unroll
          for (int u = 0; u < 16; ++u) kf[u] = frag_row(Ks, 136, 16 * (u & 3), 32 * (u >> 2), fr, fq);
          __builtin_amdgcn_sched_barrier(0);
#pragma unroll
          for (int n = 0; n < 4; ++n) S[n] = (f32x4){0.f, 0.f, 0.f, 0.f};
#pragma unroll
          for (int ks = 0; ks < 4; ++ks)
#pragma unroll
              for (int n = 0; n < 4; ++n) S[n] = MFMA16(kf[4 * ks + n], qf[ks], S[n]);
          __builtin_amdgcn_sched_barrier(0); }
        bf16x8 vf[16];
#pragma unroll
        for (int u = 0; u < 16; ++u) vf[u] = frag_vtl(Vs, 144, 16 * (u & 7), u >> 3, fr, fq);
        __builtin_amdgcn_sched_barrier(0);
        f32x4 E[4], Lh[4], Ll[4];
#pragma unroll
        for (int n = 0; n < 4; ++n) { const int sbase = kb * 64 + 16 * n + 4 * fq;
#pragma unroll
            for (int r = 0; r < 4; ++r) { const float xx = S[n][r] * 0.08838834764831845f; const float lg = __logf(1.f + __expf(-fabsf(xx)));
                const float L = -fmaxf(xx, 0.f) - lg; E[n][r] = fminf(xx, 0.f) - lg;
                const float Lm = (sbase + r < tpos) ? L : 0.f; const float hi = bf2f(f2bf(Lm));
                Lh[n][r] = hi; Ll[n][r] = Lm - hi; } }
        const bf16x8 bh0 = pack8(Lh[0], Lh[1]), bh1 = pack8(Lh[2], Lh[3]), bl0 = pack8(Ll[0], Ll[1]), bl1 = pack8(Ll[2], Ll[3]);
        f32x4 tail[4];
#pragma unroll
        for (int n = 0; n < 4; ++n) tail[n] = carry;
        tail[0] = MFMA16(U00, bh0, tail[0]); tail[0] = MFMA16(U00, bl0, tail[0]); tail[0] = MFMA16(ones, bh1, tail[0]); tail[0] = MFMA16(ones, bl1, tail[0]);
        tail[1] = MFMA16(U10, bh0, tail[1]); tail[1] = MFMA16(U10, bl0, tail[1]); tail[1] = MFMA16(ones, bh1, tail[1]); tail[1] = MFMA16(ones, bl1, tail[1]);
        tail[2] = MFMA16(U00, bh1, tail[2]); tail[2] = MFMA16(U00, bl1, tail[2]);
        tail[3] = MFMA16(U10, bh1, tail[3]); tail[3] = MFMA16(U10, bl1, tail[3]);
        carry = MFMA16(ones, bh0, carry); carry = MFMA16(ones, bl0, carry); carry = MFMA16(ones, bh1, carry); carry = MFMA16(ones, bl1, carry);
        f32x4 W[4];
#pragma unroll
        for (int n = 0; n < 4; ++n) { const int sbase = kb * 64 + 16 * n + 4 * fq;
#pragma unroll
            for (int r = 0; r < 4; ++r) W[n][r] = (sbase + r < tpos) ? __expf(E[n][r] + tail[n][r]) : 0.f; }
        const bf16x8 bw0 = pack8(W[0], W[1]), bw1 = pack8(W[2], W[3]);
#pragma unroll
        for (int n = 0; n < 8; ++n) O[n] = MFMA16(vf[n], bw0, O[n]);
#pragma unroll
        for (int n = 0; n < 8; ++n) O[n] = MFMA16(vf[8 + n], bw1, O[n]);
        { float m = carry[0]; m = fmaxf(m, __shfl_xor(m, 1)); m = fmaxf(m, __shfl_xor(m, 2)); m = fmaxf(m, __shfl_xor(m, 4)); m = fmaxf(m, __shfl_xor(m, 8)); wmax = m; }
        }
        if (lane == 0) *(LAS float*)(red + wid * 4) = wmax;
        __syncthreads();
        float bm = *(const LAS float*)(red);
#pragma unroll
        for (int w = 1; w < 8; ++w) bm = fmaxf(bm, *(const LAS float*)(red + w * 4));
        if (bm < -110.f || kb == 0) break;
        *(LAS u32x4*)(Ks + (sr * 136 + sc * 8) * 2) = kr0; *(LAS u32x4*)(Ks + ((sr + 32) * 136 + sc * 8) * 2) = kr1;
        *(LAS u32x4*)(Vs + (sr * 144 + sc * 8) * 2) = vr0; *(LAS u32x4*)(Vs + ((sr + 32) * 144 + sc * 8) * 2) = vr1;
        __syncthreads();
    }
#pragma unroll
    for (int n = 0; n < 8; ++n) { u16* gp = PJ(proj, tok0 + 16 * wid + fr, C_SG + h * 128 + 4 * fq + 16 * n); const u32x2 gv = *(const u32x2*)(gp); u32x2 o;
        o[0] = pk2(O[n][0] * siluf(bflo(gv[0])), O[n][1] * siluf(bfhi(gv[0]))); o[1] = pk2(O[n][2] * siluf(bflo(gv[1])), O[n][3] * siluf(bfhi(gv[1])));
        if (!dry) *(u32x2*)(gp) = o; }
}

__device__ __forceinline__ void mem_group(lds_t lds, u16* proj, const u16* memkv, bool dry) {
    const int tid = otid(), wid = tid >> 6, lane = tid & 63, fr = lane & 15, fq = lane >> 4;
    lds_t Km = lds, Vm = lds + 69632;
    int cur_bh = -1;
    for (int idx = blockIdx.x * 4; idx < 1024; idx += gridDim.x * 4) {
        const int bh = idx >> 6, b = bh >> 2, h = bh & 3;
        if (bh != cur_bh) { __syncthreads();
            copy_tile(Km, 136, memkv + (size_t)b * 256 * 1024 + h * 128, 1024, 256, 4);
            copy_tile(Vm, 144, memkv + (size_t)b * 256 * 1024 + 512 + h * 128, 1024, 256, 4);
            __syncthreads(); cur_bh = bh; }
        u32x4 qn[4];
        {
#pragma unroll
          for (int ks = 0; ks < 4; ++ks) qn[ks] = *(const u32x4*)PJ(proj, (size_t)b * SEQ + (idx & 63) * 128 + 16 * wid + fr, C_MQ + h * 128 + 8 * fq + 32 * ks); }
#pragma unroll 1
        for (int j = 0; j < 4; ++j) { const int tile = (idx + j) & 63;
            const size_t tok = (size_t)b * SEQ + tile * 128 + 16 * wid + fr;
            bf16x8 qf[4];
#pragma unroll
            for (int ks = 0; ks < 4; ++ks) qf[ks] = __builtin_bit_cast(bf16x8, qn[ks]);
            if (j < 3) {
#pragma unroll
                for (int ks = 0; ks < 4; ++ks) qn[ks] = *(const u32x4*)PJ(proj, tok + 128, C_MQ + h * 128 + 8 * fq + 32 * ks); }
            u32x2 gv[8];
#pragma unroll
            for (int n = 0; n < 8; ++n) gv[n] = *(const u32x2*)PJ(proj, tok, C_MG + h * 128 + 4 * fq + 16 * n);
            f32x4 S[16];
            { bf16x8 kf[2][8];
#pragma unroll
              for (int u = 0; u < 8; ++u) kf[0][u] = frag_row(Km, 136, 16 * (u >> 2), 32 * (u & 3), fr, fq);
#pragma unroll
              for (int np = 0; np < 8; ++np) {
                  if (np + 1 < 8) {
#pragma unroll
                      for (int u = 0; u < 8; ++u) kf[(np + 1) & 1][u] = frag_row(Km, 136, 16 * (2 * np + 2 + (u >> 2)), 32 * (u & 3), fr, fq); }
                  __builtin_amdgcn_sched_barrier(0);
                  S[2 * np] = (f32x4){0.f, 0.f, 0.f, 0.f}; S[2 * np + 1] = (f32x4){0.f, 0.f, 0.f, 0.f};
#pragma unroll
                  for (int ks = 0; ks < 4; ++ks) { S[2 * np] = MFMA16(kf[np & 1][ks], qf[ks], S[2 * np]); S[2 * np + 1] = MFMA16(kf[np & 1][4 + ks], qf[ks], S[2 * np + 1]); }
                  __builtin_amdgcn_sched_barrier(0); } }
            float m = S[0][0];
#pragma unroll
            for (int n = 0; n < 16; ++n)
#pragma unroll
                for (int r = 0; r < 4; ++r) m = fmaxf(m, S[n][r]);
            m = fmaxf(m, __shfl_xor(m, 16)); m = fmaxf(m, __shfl_xor(m, 32));
            float s = 0.f;
#pragma unroll
            for (int n = 0; n < 16; ++n)
#pragma unroll
                for (int r = 0; r < 4; ++r) { const float e = __expf((S[n][r] - m) * 0.08838834764831845f); S[n][r] = e; s += e; }
            s += __shfl_xor(s, 16); s += __shfl_xor(s, 32);
            const float inv = 1.f / s;
            f32x4 O[8];
#pragma unroll
            for (int n = 0; n < 8; ++n) O[n] = (f32x4){0.f, 0.f, 0.f, 0.f};
            { bf16x8 af[2][8];
#pragma unroll
              for (int n = 0; n < 8; ++n) af[0][n] = frag_vtl(Vm, 144, 16 * n, 0, fr, fq);
#pragma unroll
              for (int k2 = 0; k2 < 8; ++k2) { const bf16x8 bp = pack8(S[2 * k2], S[2 * k2 + 1]);
                  if (k2 + 1 < 8) {
#pragma unroll
                      for (int n = 0; n < 8; ++n) af[(k2 + 1) & 1][n] = frag_vtl(Vm, 144, 16 * n, k2 + 1, fr, fq); }
                  __builtin_amdgcn_sched_barrier(0);
#pragma unroll
                  for (int n = 0; n < 8; ++n) O[n] = MFMA16(af[k2 & 1][n], bp, O[n]);
                  __builtin_amdgcn_sched_barrier(0); } }
#pragma unroll
            for (int n = 0; n < 8; ++n) { u16* gp = PJ(proj, tok, C_MG + h * 128 + 4 * fq + 16 * n); u32x2 o;
                o[0] = pk2(O[n][0] * inv * siluf(bflo(gv[n][0])), O[n][1] * inv * siluf(bfhi(gv[n][0]))); o[1] = pk2(O[n][2] * inv * siluf(bflo(gv[n][1])), O[n][3] * inv * siluf(bfhi(gv[n][1])));
                if (!dry) *(u32x2*)(gp) = o; }
        }
    }
    __syncthreads();
}

__device__ __forceinline__ void ret_state_item(lds_t lds, const u16* proj, u16* retS, const float* rc, const float* rs, int it) {
    const int tid = otid(), wid = tid >> 6, lane = tid & 63, fr = lane & 15, fq = lane >> 4, wr = wid >> 1, wc = wid & 1;
    const int h = it & 3, bc = it >> 2, c = bc & 63, b = bc >> 6;
    const size_t tok0 = (size_t)b * SEQ + c * 128;
    lds_t KZ = lds, Vs = lds + 34816;
    __syncthreads();
    rope_tile(KZ, proj, tok0, C_RK + h * 128, rc, rs, c * 128, 0.08838834764831845f, ret_log2g(h));
    copy_tile_pj(Vs, 136, proj, tok0, C_RV + h * 128);
    __syncthreads();
    f32x4 acc[2][4];
#pragma unroll
    for (int m = 0; m < 2; ++m)
#pragma unroll
        for (int n = 0; n < 4; ++n) acc[m][n] = (f32x4){0.f, 0.f, 0.f, 0.f};
#pragma unroll
    for (int ks = 0; ks < 4; ++ks) { bf16x8 a[2], bq[4];
#pragma unroll
        for (int m = 0; m < 2; ++m) a[m] = frag_tr(Vs, 136, 32 * wr + 16 * m, 32 * ks, fr, fq);
#pragma unroll
        for (int n = 0; n < 4; ++n) bq[n] = frag_tr(KZ, 136, 64 * wc + 16 * n, 32 * ks, fr, fq);
#pragma unroll
        for (int m = 0; m < 2; ++m)
#pragma unroll
            for (int n = 0; n < 4; ++n) acc[m][n] = MFMA16(a[m], bq[n], acc[m][n]); }
    u16* dst = retS + (size_t)it * 16384;
#pragma unroll
    for (int m = 0; m < 2; ++m)
#pragma unroll
        for (int n = 0; n < 4; ++n)
#pragma unroll
            for (int r = 0; r < 4; ++r) dst[(32 * wr + 16 * m + 4 * fq + r) * 128 + 64 * wc + 16 * n + fr] = f2bf(acc[m][n][r]);
}

__device__ __forceinline__ void ssd_dt(lds_t acs, lds_t dlt, const float* dtraw, const float* dt_bias, const float* a_log, size_t tok0, int g) {
    const int tid = otid();
    { const int t = tid >> 2, hh = tid & 3, h = 4 * g + hh;
      const float dr = dtraw[(tok0 + t) * 8 + h] + dt_bias[h];
      const float delta = dr > 20.f ? dr : log1pf(__expf(dr));
      *(LAS float*)(dlt + tid * 4) = delta; *(LAS float*)(acs + tid * 4) = -delta * __expf(a_log[h]); }
    __syncthreads();
    if (tid < 256) { const int hh = tid >> 6, ln = tid & 63;
        const float v0 = *(const LAS float*)(acs + ((2 * ln) * 4 + hh) * 4), v1 = *(const LAS float*)(acs + ((2 * ln + 1) * 4 + hh) * 4);
        float sc = v0 + v1;
#pragma unroll
        for (int d = 1; d < 64; d <<= 1) { const float o = __shfl_up(sc, d); if (ln >= d) sc += o; }
        *(LAS float*)(acs + ((2 * ln) * 4 + hh) * 4) = sc - v1; *(LAS float*)(acs + ((2 * ln + 1) * 4 + hh) * 4) = sc; }
    __syncthreads();
}

__device__ __forceinline__ void ssd_state_item(lds_t lds, const u16* proj, u16* ssdS, float* cdec, const float* dtraw, const float* cw, const float* cb, const float* dt_bias, const float* a_log, int it) {
    const int tid = otid(), wid = tid >> 6, lane = tid & 63, fr = lane & 15, fq = lane >> 4, wr = wid >> 1, wc = wid & 1;
    const int g = it & 1, bc = it >> 1, c = bc & 63, b = bc >> 6;
    const size_t tok0 = (size_t)b * SEQ + c * 128;
    lds_t Bm = lds, XW = lds + 34816, acs = lds + 102400, dlt = lds + 104448, scl = lds + 106496;
    __syncthreads();
    ssd_dt(acs, dlt, dtraw, dt_bias, a_log, tok0, g);
    { const int hh = tid & 3; const float al = *(const LAS float*)(acs + (127 * 4 + hh) * 4);
      *(LAS float*)(scl + tid * 4) = *(const LAS float*)(dlt + tid * 4) * __expf(al - *(const LAS float*)(acs + tid * 4));
      if (tid < 4) cdec[(size_t)bc * 8 + 4 * g + tid] = __expf(al); }
    __syncthreads();
    conv_tile<16, false>(Bm, 136, proj, tok0, c * 128, 512 + g * 128, cw, cb, scl);
    conv_tile<32, true>(XW, 264, proj, tok0, c * 128, g * 256, cw, cb, scl);
    __syncthreads();
    u16* dst = ssdS + ((size_t)bc * 8 + 4 * g + wr) * 8192;
#pragma unroll 1
    for (int nh = 0; nh < 2; ++nh) {
        f32x4 acc[4][2];
#pragma unroll
        for (int m = 0; m < 4; ++m)
#pragma unroll
            for (int n = 0; n < 2; ++n) acc[m][n] = (f32x4){0.f, 0.f, 0.f, 0.f};
#pragma unroll
        for (int ks = 0; ks < 4; ++ks) { bf16x8 a[4], bq[2];
#pragma unroll
            for (int m = 0; m < 4; ++m) a[m] = frag_tr(XW, 264, 64 * wr + 16 * m, 32 * ks, fr, fq);
#pragma unroll
            for (int n = 0; n < 2; ++n) bq[n] = frag_tr(Bm, 136, 64 * wc + 32 * nh + 16 * n, 32 * ks, fr, fq);
#pragma unroll
            for (int m = 0; m < 4; ++m)
#pragma unroll
                for (int n = 0; n < 2; ++n) acc[m][n] = MFMA16(a[m], bq[n], acc[m][n]); }
#pragma unroll
        for (int m = 0; m < 4; ++m)
#pragma unroll
            for (int n = 0; n < 2; ++n)
#pragma unroll
                for (int r = 0; r < 4; ++r) dst[(16 * m + 4 * fq + r) * 128 + 64 * wc + 32 * nh + 16 * n + fr] = f2bf(acc[m][n][r]);
    }
}

__device__ __forceinline__ void scan_phase(u16* retS, u16* ssdS, const float* cdec, bool dry) {
    const int tid = otid();
    if (tid >= 256) return;
    for (int q = blockIdx.x * 256 + tid; q < 65536; q += gridDim.x * 256) {
        float st[8];
#pragma unroll
        for (int e = 0; e < 8; ++e) st[e] = 0.f;
        u16* p; const float* dp = nullptr; float dec0 = 0.f;
        if (q < 32768) { const int bh = q >> 11, e8 = q & 2047, b = bh >> 2, h = bh & 3;
            dec0 = exp2f(128.f * ret_log2g(h));
            p = retS + ((size_t)(b * 64) * 4 + h) * 16384 + e8 * 8;
        } else { const int q2 = q - 32768, bh = q2 >> 10, e8 = q2 & 1023, b = bh >> 3, h = bh & 7;
            p = ssdS + ((size_t)(b * 64) * 8 + h) * 8192 + e8 * 8; dp = cdec + (size_t)(b * 64) * 8 + h; }
#pragma unroll 16
        for (int c = 0; c < 64; ++c) { u32x4* pp = (u32x4*)(p + (size_t)c * 65536); const u32x4 v = *pp; const float dec = dp ? dp[c * 8] : dec0;
            u32x4 o;
#pragma unroll
            for (int e = 0; e < 4; ++e) o[e] = pk2(st[2 * e], st[2 * e + 1]);
            *pp = o;
#pragma unroll
            for (int e = 0; e < 4; ++e) { st[2 * e] = dec * st[2 * e] + bflo(v[e]); st[2 * e + 1] = dec * st[2 * e + 1] + bfhi(v[e]); } }
    }
}

__device__ __forceinline__ void ret_out_item(lds_t lds, u16* proj, const u16* retS, const float* rc, const float* rs, int it, bool dry) {
    const int tid = otid(), wid = tid >> 6, lane = tid & 63, fr = lane & 15, fq = lane >> 4, wr = wid >> 1, wc = wid & 1;
    const int h = it & 3, bc = it >> 2, c = bc & 63, b = bc >> 6;
    const size_t tok0 = (size_t)b * SEQ + c * 128;
    const float l2g = ret_log2g(h);
    lds_t Qs = lds, Ks = lds + 34816, Vs = lds + 69632, Rs = lds + 104448, Ys = lds;
    __syncthreads();
    rope_tile(Qs, proj, tok0, C_RQ + h * 128, rc, rs, c * 128, 1.f, 0.f);
    rope_tile(Ks, proj, tok0, C_RK + h * 128, rc, rs, c * 128, 0.08838834764831845f, 0.f);
    copy_tile_pj(Vs, 136, proj, tok0, C_RV + h * 128);
    copy_tile(Rs, 136, retS + (size_t)it * 16384, 128, 128, 4);
    __syncthreads();
    f32x4 a1[2][4], a2[2][4];
#pragma unroll
    for (int m = 0; m < 2; ++m)
#pragma unroll
        for (int n = 0; n < 4; ++n) { a1[m][n] = (f32x4){0.f, 0.f, 0.f, 0.f}; a2[m][n] = (f32x4){0.f, 0.f, 0.f, 0.f}; }
    { bf16x8 fb[2][10];
#pragma unroll
      for (int u = 0; u < 10; ++u) fb[0][u] = (u < 2) ? frag_row(Qs, 136, 32 * wr + 16 * u, 0, fr, fq) : (u < 6) ? frag_row(Ks, 136, 64 * wc + 16 * (u - 2), 0, fr, fq) : frag_row(Rs, 136, 64 * wc + 16 * (u - 6), 0, fr, fq);
#pragma unroll
      for (int ks = 0; ks < 4; ++ks) {
          if (ks + 1 < 4) {
#pragma unroll
              for (int u = 0; u < 10; ++u) fb[(ks + 1) & 1][u] = (u < 2) ? frag_row(Qs, 136, 32 * wr + 16 * u, 32 * (ks + 1), fr, fq) : (u < 6) ? frag_row(Ks, 136, 64 * wc + 16 * (u - 2), 32 * (ks + 1), fr, fq) : frag_row(Rs, 136, 64 * wc + 16 * (u - 6), 32 * (ks + 1), fr, fq); }
          __builtin_amdgcn_sched_barrier(0);
#pragma unroll
          for (int n = 0; n < 4; ++n)
#pragma unroll
              for (int m = 0; m < 2; ++m) { a1[m][n] = MFMA16(fb[ks & 1][m], fb[ks & 1][2 + n], a1[m][n]); a2[m][n] = MFMA16(fb[ks & 1][m], fb[ks & 1][6 + n], a2[m][n]); }
          __builtin_amdgcn_sched_barrier(0); } }
    __syncthreads();
#pragma unroll
    for (int m = 0; m < 2; ++m)
#pragma unroll
        for (int n = 0; n < 4; ++n)
#pragma unroll
            for (int r = 0; r < 4; ++r) { const int l = 32 * wr + 16 * m + 4 * fq + r, mm = 64 * wc + 16 * n + fr;
                const float pv = (l >= mm) ? a1[m][n][r] * exp2f(l2g * (float)(l - mm)) : 0.f;
                *(LAS u16*)(Ks + (l * 136 + mm) * 2) = f2bf(pv); }
    __syncthreads();
#pragma unroll
    for (int m = 0; m < 2; ++m)
#pragma unroll
        for (int n = 0; n < 4; ++n) a1[m][n] = (f32x4){0.f, 0.f, 0.f, 0.f};
    { bf16x8 fb[2][6];
#pragma unroll
      for (int u = 0; u < 6; ++u) fb[0][u] = (u < 2) ? frag_row(Ks, 136, 32 * wr + 16 * u, 0, fr, fq) : frag_tr(Vs, 136, 64 * wc + 16 * (u - 2), 0, fr, fq);
#pragma unroll
      for (int ks = 0; ks < 4; ++ks) {
          if (ks + 1 < 4) {
#pragma unroll
              for (int u = 0; u < 6; ++u) fb[(ks + 1) & 1][u] = (u < 2) ? frag_row(Ks, 136, 32 * wr + 16 * u, 32 * (ks + 1), fr, fq) : frag_tr(Vs, 136, 64 * wc + 16 * (u - 2), 32 * (ks + 1), fr, fq); }
          __builtin_amdgcn_sched_barrier(0);
#pragma unroll
          for (int n = 0; n < 4; ++n)
#pragma unroll
              for (int m = 0; m < 2; ++m) a1[m][n] = MFMA16(fb[ks & 1][m], fb[ks & 1][2 + n], a1[m][n]);
          __builtin_amdgcn_sched_barrier(0); } }
    __syncthreads();
#pragma unroll
    for (int m = 0; m < 2; ++m)
#pragma unroll
        for (int r = 0; r < 4; ++r) { const int l = 32 * wr + 16 * m + 4 * fq + r; const float xi = exp2f(l2g * (float)(l + 1));
#pragma unroll
            for (int n = 0; n < 4; ++n) *(LAS float*)(Ys + (l * 132 + 64 * wc + 16 * n + fr) * 4) = a1[m][n][r] + xi * a2[m][n][r]; }
    __syncthreads();
    { const int r = tid >> 2, q4 = tid & 3; float v[32]; float s = 0.f;
#pragma unroll
      for (int i = 0; i < 8; ++i) { const f32x4 t = *(const LAS f32x4*)(Ys + (r * 132 + q4 * 32 + i * 4) * 4); v[4 * i] = t[0]; v[4 * i + 1] = t[1]; v[4 * i + 2] = t[2]; v[4 * i + 3] = t[3]; s += t[0] + t[1] + t[2] + t[3]; }
      s += __shfl_xor(s, 1); s += __shfl_xor(s, 2); const float mu = s * (1.f / 128.f);
      float q = 0.f;
#pragma unroll
      for (int i = 0; i < 32; ++i) { v[i] -= mu; q += v[i] * v[i]; }
      q += __shfl_xor(q, 1); q += __shfl_xor(q, 2); const float rstd = rsqrtf(q * (1.f / 128.f) + EPS);
      u16* gp = PJ(proj, tok0 + r, C_RG + h * 128 + q4 * 32);
#pragma unroll
      for (int i = 0; i < 4; ++i) { const u32x4 gv = *(const u32x4*)(gp + i * 8); u32x4 o;
#pragma unroll
          for (int e = 0; e < 4; ++e) o[e] = pk2(v[8 * i + 2 * e] * rstd * siluf(bflo(gv[e])), v[8 * i + 2 * e + 1] * rstd * siluf(bfhi(gv[e])));
          if (!dry) *(u32x4*)(gp + i * 8) = o; } }
}

__device__ __forceinline__ bf16x8 frag_vt_ld(lds_t base, int ld, int e0, int k2, int fr, int fq) {
    lds_t p = base + ((32 * k2 + 4 * fq + (fr >> 2)) * ld + e0 + 4 * (fr & 3)) * 2;
    const s16x4 lo = trrd(p), hi = trrd(p + 16 * ld * 2);
    return (bf16x8){lo[0], lo[1], lo[2], lo[3], hi[0], hi[1], hi[2], hi[3]};
}
__device__ __forceinline__ void ssd_out_item(lds_t lds, u16* proj, const u16* ssdS, const float* dtraw, const float* cw, const float* cb, const float* dt_bias, const float* a_log,
                                             const float* d_skip, const float* norm_g, int it, bool dry) {
    const int tid = otid(), wid = tid >> 6, lane = tid & 63, fr = lane & 15, fq = lane >> 4;
    const int g = it & 1, bc = it >> 1, c = bc & 63, b = bc >> 6;
    const size_t tok0 = (size_t)b * SEQ + c * 128;
    lds_t Cs = lds, Bm = lds + 34816, XS = lds + 69632, acs = lds + 139264, dlt = lds + 141312, acsT = lds + 143360, dltT = lds + 145408, ssq = lds + 147456;
    __syncthreads();
    ssd_dt(acs, dlt, dtraw, dt_bias, a_log, tok0, g);
    { const int t = tid >> 2, hh = tid & 3; *(LAS float*)(acsT + (hh * 128 + t) * 4) = *(const LAS float*)(acs + tid * 4); *(LAS float*)(dltT + (hh * 128 + t) * 4) = *(const LAS float*)(dlt + tid * 4); }
    conv_tile<16, false>(Cs, 136, proj, tok0, c * 128, 768 + g * 128, cw, cb, acs);
    conv_tile<16, false>(Bm, 136, proj, tok0, c * 128, 512 + g * 128, cw, cb, acs);
    conv_tile<32, false>(XS, 272, proj, tok0, c * 128, g * 256, cw, cb, acs);
    __syncthreads();
    const int l = 16 * wid + fr;
    bf16x8 cf[4];
#pragma unroll
    for (int ks = 0; ks < 4; ++ks) cf[ks] = frag_row(Cs, 136, 16 * wid, 32 * ks, fr, fq);
    f32x4 cbT[8];
    { bf16x8 kf[2][8];
#pragma unroll
      for (int u = 0; u < 8; ++u) kf[0][u] = frag_row(Bm, 136, 16 * (u >> 2), 32 * (u & 3), fr, fq);
#pragma unroll
      for (int np = 0; np < 4; ++np) {
          if (np + 1 < 4) {
#pragma unroll
              for (int u = 0; u < 8; ++u) kf[(np + 1) & 1][u] = frag_row(Bm, 136, 16 * (2 * np + 2 + (u >> 2)), 32 * (u & 3), fr, fq); }
          __builtin_amdgcn_sched_barrier(0);
          cbT[2 * np] = (f32x4){0.f, 0.f, 0.f, 0.f}; cbT[2 * np + 1] = (f32x4){0.f, 0.f, 0.f, 0.f};
#pragma unroll
          for (int ks = 0; ks < 4; ++ks) { cbT[2 * np] = MFMA16(kf[np & 1][ks], cf[ks], cbT[2 * np]); cbT[2 * np + 1] = MFMA16(kf[np & 1][4 + ks], cf[ks], cbT[2 * np + 1]); }
          __builtin_amdgcn_sched_barrier(0); } }
    u16* gp = PJ(proj, tok0 + l, C_Z + g * 256 + 4 * fq);
#pragma unroll 1
    for (int hh = 0; hh < 4; ++hh) {
        const int h = 4 * g + hh;
        const u16* pv = ssdS + ((size_t)bc * 8 + h) * 8192 + (size_t)fr * 128 + 8 * fq;
        const float al = *(const LAS float*)(acsT + (hh * 128 + l) * 4);
        bf16x8 pf[16];
#pragma unroll
        for (int u = 0; u < 16; ++u) pf[u] = __builtin_bit_cast(bf16x8, *(const u32x4*)(pv + (size_t)(u >> 2) * 2048 + 32 * (u & 3)));
        bf16x8 bp[4];
#pragma unroll
        for (int k2 = 0; k2 < 4; ++k2) { f32x4 pa[2];
#pragma unroll
            for (int u = 0; u < 2; ++u) { const int n = 2 * k2 + u, s0 = 16 * n + 4 * fq;
                const f32x4 as = *(const LAS f32x4*)(acsT + (hh * 128 + s0) * 4), ds = *(const LAS f32x4*)(dltT + (hh * 128 + s0) * 4);
#pragma unroll
                for (int r = 0; r < 4; ++r) pa[u][r] = (s0 + r <= l) ? cbT[n][r] * __expf(al - as[r]) * ds[r] : 0.f; }
            bp[k2] = pack8(pa[0], pa[1]); }
        f32x4 yd[4], yo[4];
#pragma unroll
        for (int m = 0; m < 4; ++m) { yd[m] = (f32x4){0.f, 0.f, 0.f, 0.f}; yo[m] = (f32x4){0.f, 0.f, 0.f, 0.f}; }
#pragma unroll
        for (int hf = 0; hf < 2; ++hf) { bf16x8 xf[8];
#pragma unroll
            for (int u = 0; u < 8; ++u) xf[u] = frag_vt_ld(XS, 272, hh * 64 + 16 * (2 * hf + (u >> 2)), u & 3, fr, fq);
            __builtin_amdgcn_sched_barrier(0);
#pragma unroll
            for (int k2 = 0; k2 < 4; ++k2) { yd[2 * hf] = MFMA16(xf[k2], bp[k2], yd[2 * hf]); yd[2 * hf + 1] = MFMA16(xf[4 + k2], bp[k2], yd[2 * hf + 1]);
                yo[2 * hf] = MFMA16(pf[8 * hf + k2], cf[k2], yo[2 * hf]); yo[2 * hf + 1] = MFMA16(pf[8 * hf + 4 + k2], cf[k2], yo[2 * hf + 1]); }
            __builtin_amdgcn_sched_barrier(0); }
        const float dsk = d_skip[h], ea = __expf(al);
        float part = 0.f;
#pragma unroll
        for (int m = 0; m < 4; ++m) { const u32x2 xw = *(const LAS u32x2*)(XS + (l * 272 + hh * 64 + 16 * m + 4 * fq) * 2);
            u16* gz = PJ(proj, tok0 + l, C_Z + g * 256 + hh * 64 + 16 * m + 4 * fq);
            const u32x2 zw = *(const u32x2*)(gz);
            const float v0 = (yd[m][0] + ea * yo[m][0] + dsk * bflo(xw[0])) * siluf(bflo(zw[0])), v1 = (yd[m][1] + ea * yo[m][1] + dsk * bfhi(xw[0])) * siluf(bfhi(zw[0]));
            const float v2 = (yd[m][2] + ea * yo[m][2] + dsk * bflo(xw[1])) * siluf(bflo(zw[1])), v3 = (yd[m][3] + ea * yo[m][3] + dsk * bfhi(xw[1])) * siluf(bfhi(zw[1]));
            u32x2 o; o[0] = pk2(v0, v1); o[1] = pk2(v2, v3);
            if (!dry) *(u32x2*)(gz) = o;
            part += v0 * v0 + v1 * v1 + v2 * v2 + v3 * v3; }
        part += __shfl_xor(part, 16); part += __shfl_xor(part, 32);
        if (fq == 0) *(LAS float*)(ssq + (l * 4 + hh) * 4) = part;
    }
    __syncthreads();
    { const int r = tid >> 2, q4 = tid & 3;
      const f32x4 p0 = *(const LAS f32x4*)(ssq + r * 16);
      const float ss = p0[0] + p0[1] + p0[2] + p0[3];
      const float rr = rsqrtf(ss * (1.f / 256.f) + EPS);
      const int gqc = C_Z + g * 256 + q4 * 64;
      const float* ng = norm_g + g * 256 + q4 * 64;
#pragma unroll
      for (int i = 0; i < 8; ++i) { u16* gq = PJ(proj, tok0 + r, gqc + i * 8); const u32x4 zv = *(const u32x4*)(gq); const f32x4 g0 = *(const f32x4*)(ng + i * 8), g1 = *(const f32x4*)(ng + i * 8 + 4); u32x4 o;
          o[0] = pk2(bflo(zv[0]) * rr * g0[0], bfhi(zv[0]) * rr * g0[1]); o[1] = pk2(bflo(zv[1]) * rr * g0[2], bfhi(zv[1]) * rr * g0[3]);
          o[2] = pk2(bflo(zv[2]) * rr * g1[0], bfhi(zv[2]) * rr * g1[1]); o[3] = pk2(bflo(zv[3]) * rr * g1[2], bfhi(zv[3]) * rr * g1[3]);
          if (!dry) *(u32x4*)(gq) = o; } }
}

#define XB_TMO      128
#define XB_XCNT(j)  (256  + 64 * (j))
#define XB_XSUB(j)  (1280 + 64 * (j))
#define XB_XGEN(j)  (2304 + 64 * (j))
#define XB_TOP      3328
#define XB_TOPGEN   3392
#define XCD_BAR_WORDS 3456
#define XB_SPIN_CAP (1u << 18)

__device__ __forceinline__ unsigned xb_ld(unsigned* p)              { return __hip_atomic_load(p, __ATOMIC_RELAXED, __HIP_MEMORY_SCOPE_AGENT); }
__device__ __forceinline__ unsigned xb_add(unsigned* p, unsigned v) { return __hip_atomic_fetch_add(p, v, __ATOMIC_RELAXED, __HIP_MEMORY_SCOPE_AGENT); }
__device__ __forceinline__ unsigned xb_xcc_id() { return (unsigned)__builtin_amdgcn_s_getreg((3 << 11) | 20) & 0xFu; }
#define XB_SPIN(cond, bar) do { unsigned _sp = 0; while (cond) { __builtin_amdgcn_s_sleep(1); \
    if ((++_sp & 255u) == 0u) { if (xb_ld(&(bar)[XB_TMO])) break; if (_sp > XB_SPIN_CAP) { atomicAdd(&(bar)[XB_TMO], 1u); break; } } } } while (0)

struct XcdBarrier {
    unsigned* bar; unsigned x;
    volatile LAS unsigned* st;
};

__device__ __forceinline__ XcdBarrier xcd_barrier_post(unsigned* bar, volatile LAS unsigned* st) {
    XcdBarrier b; b.bar = bar; b.x = xb_xcc_id(); b.st = st;
    if (threadIdx.x == 0) (void)xb_add(&bar[XB_XCNT(b.x)], 1u);
    return b;
}
__device__ __forceinline__ void xcd_barrier_complete(unsigned* bar, unsigned x, unsigned& nloc, unsigned& nx) {
    const unsigned G = gridDim.x * gridDim.y * gridDim.z;
    unsigned sum, cnt, mine, sp = 0u;
    for (;;) {
        sum = 0u; cnt = 0u; mine = 0u;
#pragma unroll
        for (unsigned j = 0; j < 16; ++j) { const unsigned c = xb_ld(&bar[XB_XCNT(j)]); sum += c; cnt += (c > 0u) ? 1u : 0u; mine = (j == x) ? c : mine; }
        if (sum == G) break;
        __builtin_amdgcn_s_sleep(1);
        if ((++sp & 255u) == 0u) { if (xb_ld(&bar[XB_TMO])) break; if (sp > XB_SPIN_CAP) { atomicAdd(&bar[XB_TMO], 1u); break; } }
    }
    nloc = mine > 0u ? mine : 1u; nx = cnt > 0u ? cnt : 1u;
}

__device__ __forceinline__ void xcd_barrier(const XcdBarrier& b) {
    asm volatile("s_waitcnt vmcnt(0)" ::: "memory");
    __syncthreads();
    if (threadIdx.x == 0) {
        unsigned* bar = b.bar;
        __builtin_amdgcn_s_waitcnt(0);
        unsigned nloc = b.st[0], nx = b.st[1];
        if (nloc == 0u) { xcd_barrier_complete(bar, b.x, nloc, nx); b.st[0] = nloc; b.st[1] = nx; }
        const unsigned old = xb_add(&bar[XB_XSUB(b.x)], 1u);
        const unsigned gen = old / nloc;
        if (old + 1u == (gen + 1u) * nloc) {
            __builtin_amdgcn_fence(__ATOMIC_RELEASE, "agent");
            asm volatile("s_waitcnt vmcnt(0)" ::: "memory");
            const unsigned og = xb_add(&bar[XB_TOP], 1u);
            const unsigned tg = og / nx;
            if (og + 1u == (tg + 1u) * nx) xb_add(&bar[XB_TOPGEN], 1u);
            else XB_SPIN(xb_ld(&bar[XB_TOPGEN]) == tg, bar);
            __builtin_amdgcn_fence(__ATOMIC_ACQUIRE, "agent");
            xb_add(&bar[XB_XGEN(b.x)], 1u);
            asm volatile("s_waitcnt vmcnt(0)" ::: "memory");
        } else {
            XB_SPIN(xb_ld(&bar[XB_XGEN(b.x)]) == gen, bar);
            __builtin_amdgcn_fence(__ATOMIC_ACQUIRE, "agent");
            asm volatile("s_waitcnt vmcnt(0)" ::: "memory");
        }
    }
    __syncthreads();
}


__global__ void __launch_bounds__(NTHR, 2) hybrid_fwd(Params p0) {
    extern __shared__ __attribute__((aligned(16))) unsigned char shm_raw[];
    lds_t lds = (lds_t)shm_raw;
    cg::grid_group grid = cg::this_grid();
    volatile LAS unsigned* xst = (volatile LAS unsigned*)(lds + LDS_BYTES - 16);
    if (threadIdx.x == 0) { xst[0] = 0u; xst[1] = 0u; }
    __syncthreads();
    const XcdBarrier xb = xcd_barrier_post((unsigned*)(p0.ws + WS_BAR), xst);
    for (int pi = p0.ph_lo; pi < p0.ph_hi; ++pi) {
        if (pi > p0.ph_lo) { if (p0.ph_lo < 0) grid.sync();
            xcd_barrier(xb); }
        const int ph = p0.prog[pi] & 63; const bool dry = (p0.prog[pi] & 64) != 0; const int im = dry ? p0.dmask : 1023;
        Params p = p0;
        asm volatile("" : "+s"(p.ws), "+s"(p.out));
        u16* proj = (u16*)(p.ws + WS_PROJ);
        u16* retS = (u16*)(p.ws + WS_ST); u16* ssdS = retS + 16777216; u16* yh = retS;
        u16* WinT = (u16*)(p.ws + WS_WIN); u16* WoutT = (u16*)(p.ws + WS_WOUT); u16* memkv = (u16*)(p.ws + WS_MEMKV);
        const float* rc = (const float*)(p.ws + WS_ROPE); const float* rs = rc + SEQ * 64;
        float* dtraw = (float*)(p.ws + WS_DT); float* cdec = (float*)(p.ws + WS_CDEC);
        if (ph == 0) { if (PM & 1) phase_prep(lds, p); continue; }
        const int layer = (ph - 1) / 6, k = (ph - 1) % 6;
        if (k == 0 || k == 4 || (k == 2 && layer == 0 && !dry)) {
            const int njobs = (k == 2) ? 3 : 1;
            for (int j = (k == 2) ? 1 : 0; j < njobs; ++j) {
                pg8::Gemm g; int c = blockIdx.x;
                g.astream = 0; g.ostream = 0;
                if (k == 0) { g.A = yh; g.lda = 1024; g.Bt = WinT; g.ldb = 1024; g.M = T_TOK; g.N = NP; g.K = 1024; g.O = proj; g.ldc = NP; g.ostream = 1; }
                else if (k == 2) { const int l = j - 1; g.A = (const u16*)p.out + (size_t)l * 1048576; g.lda = 1024; g.Bt = (const u16*)p.out + 2097152 + (size_t)l * 1048576; g.ldb = 1024;
                    g.M = 1024; g.N = 1024; g.K = 1024; g.O = memkv + (size_t)l * 1048576; g.ldc = 1024; c = (int)((blockIdx.x + gridDim.x - 16u * l) % gridDim.x); }
                else { g.A = proj + (size_t)(C_RG >> 5) * STRM; g.lda = 32; g.astream = 1; g.Bt = WoutT; g.ldb = 2048; g.M = T_TOK; g.N = 1024; g.K = 2048; g.O = yh; g.ldc = 1024; }
                pg8::StaticOrder S; S.init(g.M, g.N, (int)gridDim.x, c);
                if (PM & 2) pg8::gemm_phase(lds, g, S);
            }
        } else if (k == 1) {
            const float* cw = p.conv_w + (size_t)layer * 4096; const float* cbias = p.conv_b + (size_t)layer * 1024;
            for (int it = blockIdx.x; it < 2560; it += gridDim.x) {
                if (it < 1024) { if (im & 4) sb_item(lds, proj, (it & ~63) | ((it + 16 * ((it >> 8) & 3)) & 63), dry); }
                else if (it < 2048) { const int i2 = it - 1024; if (im & 16) ret_state_item(lds, proj, retS, rc, rs, (i2 & ~(63 << 2)) | ((((i2 >> 2) + 16 * ((i2 >> 8) & 3)) & 63) << 2)); }
                else { const int i2 = it - 2048; if (im & 32) ssd_state_item(lds, proj, ssdS, cdec, dtraw, cw, cbias, p.dt_bias + layer * 8, p.a_log + layer * 8, (i2 & ~(63 << 1)) | ((((i2 >> 1) + 16 * ((i2 >> 8) & 1)) & 63) << 1)); }
            }
        }
        if (k == 2) {
            if ((PM & 64) && !dry) scan_phase(retS, ssdS, cdec, dry);
        } else if (k == 3) {
            const float* cw = p.conv_w + (size_t)layer * 4096; const float* cbias = p.conv_b + (size_t)layer * 1024;
            for (int it = blockIdx.x; it < 1536; it += gridDim.x) {
                if (it < 1024) { if (im & 128) ret_out_item(lds, proj, retS, rc, rs, (it & ~(63 << 2)) | ((((it >> 2) + 16 * ((it >> 8) & 3)) & 63) << 2), dry); }
                else { if (im & 256) ssd_out_item(lds, proj, ssdS, dtraw, cw, cbias, p.dt_bias + layer * 8, p.a_log + layer * 8, p.d_skip + layer * 8, p.ssd_norm_g + layer * 512, ((it - 1024) & ~(63 << 1)) | (((((it - 1024) >> 1) + 16 * (((it - 1024) >> 8) & 1)) & 63) << 1), dry); }
            }
            if (im & 8) mem_group(lds, proj, memkv + (size_t)layer * 1048576, dry);
        } else if (k == 5) {
            const bool has_next = layer == 0;
            if (has_next) { convert_win(lds, p.w_in + (size_t)1024 * DIN, WinT); convert_wout(lds, p.w_out + (size_t)2048 * 1024, WoutT); }
            if (PM & 512) row_pass(lds, layer == 0 ? p.x : p.out, p.out, yh, true, p.post_g + layer * 1024, has_next, p.pre_g + 1024, p.w_in + (size_t)1024 * DIN, dtraw, dry);
        }
    }
}


#ifdef DBG_STOP
__global__ void dbg_dump(Params p) {
    const u16* proj = (const u16*)(p.ws + WS_PROJ); const u16* st = (const u16*)(p.ws + WS_ST);
    const u16* mk = (const u16*)(p.ws + WS_MEMKV); const float* dt = (const float*)(p.ws + WS_DT); const float* cd = (const float*)(p.ws + WS_CDEC);
    const float* rp = (const float*)(p.ws + WS_ROPE);
    for (size_t i = (size_t)blockIdx.x * blockDim.x + threadIdx.x; i < (size_t)T_TOK * DM; i += (size_t)gridDim.x * blockDim.x) {
        float a = 0.f;
#if DBG_WHAT & 1
        for (int j = 0; j < 6; ++j) a += bf2f(proj[i * 6 + j]);
        a += bf2f(proj[201326592ull + (i >> 1)]);
#endif
#if DBG_WHAT & 2
        a += bf2f(st[i]);
#endif
#if DBG_WHAT & 4
        a += bf2f(mk[i & 2097151]) + dt[i & 262143] + cd[i & 2047] + rp[i & 1048575];
#endif
        p.out[i] = a;
    }
}
#endif

#ifdef DBG_STOP
constexpr int N_PHASES = DBG_STOP;
#else
constexpr int N_PHASES = 13;
#endif

extern "C" void kernel_launch(void* const* d_in, const int* in_sizes, int n_in, void* d_out, int out_size, void* d_ws, size_t ws_size, hipStream_t stream) {
    static int grid = 0;
    if (grid == 0) {
        if (n_in != 14 || in_sizes[0] != T_TOK * DM || out_size != T_TOK * DM || ws_size < WS_END) {
            fprintf(stderr, "kernel_launch: unexpected shapes (n_in %d, in0 %d, out %d, ws %zu need %zu)\n", n_in, n_in > 0 ? in_sizes[0] : -1, out_size, ws_size, (size_t)WS_END); grid = -1; return; }
        int dev = 0, cus = 0, per_cu = 0;
        hipGetDevice(&dev); hipDeviceGetAttribute(&cus, hipDeviceAttributeMultiprocessorCount, dev);
        if (hipFuncSetAttribute((const void*)hybrid_fwd, hipFuncAttributeMaxDynamicSharedMemorySize, LDS_BYTES) != hipSuccess) { fprintf(stderr, "kernel_launch: hipFuncSetAttribute failed\n"); grid = -1; return; }
        if (hipOccupancyMaxActiveBlocksPerMultiprocessor(&per_cu, (const void*)hybrid_fwd, NTHR, LDS_BYTES) != hipSuccess || per_cu < 1) per_cu = 1;
        (void)hipGetLastError();
        grid = cus * 1;
    }
    if (grid < 0) return;
    if (hipMemsetAsync((char*)d_ws + WS_BAR, 0, 16384, stream) != hipSuccess) { fprintf(stderr, "kernel_launch: memset failed\n"); return; }
    Params p{};
    p.x = (const float*)d_in[0]; p.mem = (const float*)d_in[1]; p.pre_g = (const float*)d_in[2]; p.post_g = (const float*)d_in[3]; p.w_in = (const float*)d_in[4];
    p.conv_w = (const float*)d_in[5]; p.conv_b = (const float*)d_in[6]; p.dt_bias = (const float*)d_in[7]; p.a_log = (const float*)d_in[8]; p.d_skip = (const float*)d_in[9];
    p.ssd_norm_g = (const float*)d_in[10]; p.mem_norm_g = (const float*)d_in[11]; p.w_mem_kv = (const float*)d_in[12]; p.w_out = (const float*)d_in[13];
    p.out = (float*)d_out; p.ws = (unsigned char*)d_ws;
    int np = 0;
#ifdef DMASK
    p.dmask = DMASK;
#else
    p.dmask = 1023;
#endif
    for (int ph = 0; ph < N_PHASES; ++ph) { p.prog[np++] = (unsigned char)ph;
#ifdef DUP_PHASE
        if (ph == DUP_PHASE) for (int d = 0; d < DUP_TIMES; ++d) p.prog[np++] = (unsigned char)(ph | 64);
#endif
    }
#if N_LAUNCH_MODE == 1
    p.ph_lo = 0; p.ph_hi = np;
    void* args[] = {&p};
    hipError_t e = hipLaunchCooperativeKernel((const void*)hybrid_fwd, dim3(grid), dim3(NTHR), args, LDS_BYTES, stream);
    if (e != hipSuccess) fprintf(stderr, "cooperative launch failed: %s (grid %d)\n", hipGetErrorString(e), grid);
#else
    for (int ph = 0; ph < np; ++ph) { p.ph_lo = ph; p.ph_hi = ph + 1; hipLaunchKernelGGL(hybrid_fwd, dim3(grid), dim3(NTHR), LDS_BYTES, stream, p); }
#ifdef DBG_STOP
    p.ph_lo = 0; p.ph_hi = 0; hipLaunchKernelGGL(dbg_dump, dim3(2048), dim3(256), 0, stream, p);
#endif
#endif
}
```

```cpp
#include <hip/hip_runtime.h>
#include <hip/hip_cooperative_groups.h>
#include <cstdio>
namespace cg = cooperative_groups;

#define LAS __attribute__((address_space(3)))
typedef unsigned short u16;
typedef short bf16x8 __attribute__((ext_vector_type(8)));
typedef short s16x4 __attribute__((ext_vector_type(4)));
typedef float f32x4 __attribute__((ext_vector_type(4)));
typedef unsigned u32x4 __attribute__((ext_vector_type(4)));
typedef unsigned u32x2 __attribute__((ext_vector_type(2)));
typedef LAS unsigned char* lds_t;

#ifndef N_LAUNCH_MODE
#define N_LAUNCH_MODE 1
#endif

constexpr int T_TOK = 32768, SEQ = 8192, DM = 1024, NP = 6656, DIN = 6664, NCHUNK = 64;
constexpr int C_RQ = 0, C_RK = 512, C_RV = 1024, C_XBC = 1536, C_SQ = 2560, C_SK = 3072, C_SV = 3584, C_MQ = 4096,
              C_RG = 4608, C_Z = 5120, C_SG = 5632, C_MG = 6144;
constexpr float EPS = 1e-6f;
constexpr int NTHR = 512;
#ifndef PM
#define PM 1023
#endif
constexpr int LDS_BYTES = 151552;

constexpr size_t WS_PROJ = 0;
constexpr size_t WS_ST = 436207616ull;
constexpr size_t WS_WIN = WS_ST + 67108864ull;
constexpr size_t WS_WOUT = WS_WIN + 13631488ull;
constexpr size_t WS_MEMKV = WS_WOUT + 4194304ull;
constexpr size_t WS_ROPE = WS_MEMKV + 4194304ull;
constexpr size_t WS_DT = WS_ROPE + 4194304ull;
constexpr size_t WS_CDEC = WS_DT + 1048576ull;
constexpr size_t WS_BAR = WS_CDEC + 8192ull;
constexpr size_t WS_END = WS_BAR + 16384ull;

constexpr size_t STRM = (size_t)T_TOK * 32;
__device__ __forceinline__ unsigned short* PJ(unsigned short* proj, size_t tok, int col) { return proj + (size_t)(col >> 5) * STRM + tok * 32 + (col & 31); }
__device__ __forceinline__ const unsigned short* PJ(const unsigned short* proj, size_t tok, int col) { return proj + (size_t)(col >> 5) * STRM + tok * 32 + (col & 31); }

struct Params {
    const float* x; const float* mem; const float* pre_g; const float* post_g; const float* w_in; const float* conv_w; const float* conv_b;
    const float* dt_bias; const float* a_log; const float* d_skip; const float* ssd_norm_g; const float* mem_norm_g; const float* w_mem_kv; const float* w_out;
    float* out; unsigned char* ws; int ph_lo, ph_hi; unsigned char prog[32]; int dmask, pad_;
};

typedef __bf16 bf16x2_t __attribute__((ext_vector_type(2)));
typedef float f32x2_t __attribute__((ext_vector_type(2)));
__device__ __forceinline__ unsigned pk2(float lo, float hi) { const f32x2_t v = {lo, hi}; const bf16x2_t b = __builtin_convertvector(v, bf16x2_t); return __builtin_bit_cast(unsigned, b); }
__device__ __forceinline__ u16 f2bf(float f) { return (u16)(pk2(f, 0.f) & 0xffffu); }
__device__ __forceinline__ float bf2f(u16 b) { return __uint_as_float(((unsigned)b) << 16); }
__device__ __forceinline__ float bflo(unsigned w) { return __uint_as_float(w << 16); }
__device__ __forceinline__ float bfhi(unsigned w) { return __uint_as_float(w & 0xffff0000u); }
__device__ __forceinline__ float siluf(float v) { return v / (1.f + __expf(-v)); }
__device__ __forceinline__ float softplusf(float x) { return fmaxf(x, 0.f) + log1pf(__expf(-fabsf(x))); }
__device__ __forceinline__ int otid() { int t = __builtin_amdgcn_workitem_id_x(); asm volatile("" : "+v"(t)); return t; }
#define MFMA16(a, b, c) __builtin_amdgcn_mfma_f32_16x16x32_bf16(a, b, c, 0, 0, 0)

__device__ __forceinline__ bf16x8 frag_row(lds_t base, int ld, int i0, int k0, int fr, int fq) {
    return *(const LAS bf16x8*)(base + ((i0 + fr) * ld + k0 + fq * 8) * 2);
}
__device__ __forceinline__ s16x4 trrd(lds_t p) { return __builtin_bit_cast(s16x4, __builtin_amdgcn_ds_read_tr16_b64_v4i16((LAS s16x4*)p)); }
__device__ __forceinline__ bf16x8 frag_tr(lds_t base, int ld, int i0, int k0, int fr, int fq) {
    lds_t p = base + ((k0 + 8 * fq + (fr >> 2)) * ld + i0 + 4 * (fr & 3)) * 2;
    const s16x4 lo = trrd(p), hi = trrd(p + 8 * ld);
    return (bf16x8){lo[0], lo[1], lo[2], lo[3], hi[0], hi[1], hi[2], hi[3]};
}
__device__ __forceinline__ void copy_tile(lds_t dst, int ldd, const u16* src, size_t lds_, int rows, int cpr_shift) {
    const int n = rows << cpr_shift;
#pragma unroll
    for (int i = otid(); i < n; i += NTHR) { const int r = i >> cpr_shift, ch = i & ((1 << cpr_shift) - 1);
        const u32x4 v = *(const u32x4*)(src + (size_t)r * lds_ + ch * 8);
        *(LAS u32x4*)(dst + (r * ldd + ch * 8) * 2) = v; }
}
__device__ __forceinline__ void copy_tile_pj(lds_t dst, int ldd, const unsigned short* proj, size_t tok0, int col) {
#pragma unroll
    for (int i = otid(); i < 2048; i += NTHR) { const int r = (i >> 2) & 127, ch = ((i >> 9) << 2) | (i & 3);
        const u32x4 v = *(const u32x4*)PJ(proj, tok0 + r, col + ch * 8);
        *(LAS u32x4*)(dst + (r * ldd + ch * 8) * 2) = v; }
}
__device__ __forceinline__ void rope_tile(lds_t dst, const u16* proj, size_t tok0, int col, const float* rc, const float* rs, int pos0, float bscale, float zl2) {
#pragma unroll
    for (int i = otid(); i < 1024; i += NTHR) { const int m = (i >> 2) & 127, ch = ((i >> 9) << 2) | (i & 3);
        const u32x4 a = *(const u32x4*)PJ(proj, tok0 + m, col + ch * 8), b = *(const u32x4*)PJ(proj, tok0 + m, col + 64 + ch * 8);
        const float* cp = rc + (size_t)(pos0 + m) * 64 + ch * 8; const float* sp = rs + (size_t)(pos0 + m) * 64 + ch * 8;
        const f32x4 c0 = *(const f32x4*)cp, c1 = *(const f32x4*)(cp + 4), s0 = *(const f32x4*)sp, s1 = *(const f32x4*)(sp + 4);
        const float sc = bscale * exp2f(zl2 * (float)(127 - m));
        float t1[8], t2[8], cc[8], ss[8], o1[8], o2[8];
#pragma unroll
        for (int e = 0; e < 4; ++e) { t1[2 * e] = bflo(a[e]); t1[2 * e + 1] = bfhi(a[e]); t2[2 * e] = bflo(b[e]); t2[2 * e + 1] = bfhi(b[e]);
            cc[e] = c0[e]; cc[e + 4] = c1[e]; ss[e] = s0[e]; ss[e + 4] = s1[e]; }
#pragma unroll
        for (int e = 0; e < 8; ++e) { o1[e] = (t1[e] * cc[e] - t2[e] * ss[e]) * sc; o2[e] = (t2[e] * cc[e] + t1[e] * ss[e]) * sc; }
        u32x4 w1, w2;
#pragma unroll
        for (int e = 0; e < 4; ++e) { w1[e] = pk2(o1[2 * e], o1[2 * e + 1]); w2[e] = pk2(o2[2 * e], o2[2 * e + 1]); }
        *(LAS u32x4*)(dst + (m * 136 + ch * 8) * 2) = w1; *(LAS u32x4*)(dst + (m * 136 + 64 + ch * 8) * 2) = w2; }
}
template <int NCH, bool SCALE>
__device__ __forceinline__ void conv_tile(lds_t dst, int ldd, const u16* proj, size_t tok0, int pos0, int ch0, const float* cw, const float* cb, lds_t scl) {
    constexpr int TPC = NTHR / NCH, RPT = 128 / TPC;
    const int t = otid(), chunk = t % NCH, rs0 = (t / NCH) * RPT, ch = ch0 + chunk * 8;
    float w[4][8], bias[8];
#pragma unroll
    for (int j = 0; j < 4; ++j) { const f32x4 a = *(const f32x4*)(cw + j * 1024 + ch), b = *(const f32x4*)(cw + j * 1024 + ch + 4);
#pragma unroll
        for (int e = 0; e < 4; ++e) { w[j][e] = a[e]; w[j][e + 4] = b[e]; } }
    { const f32x4 a = *(const f32x4*)(cb + ch), b = *(const f32x4*)(cb + ch + 4);
#pragma unroll
      for (int e = 0; e < 4; ++e) { bias[e] = a[e]; bias[e + 4] = b[e]; } }
    u32x4 x[RPT + 3];
#pragma unroll
    for (int i = 0; i < RPT + 3; ++i) { const int rr = rs0 - 3 + i; x[i] = (u32x4){0u, 0u, 0u, 0u};
        if (pos0 + rr >= 0) x[i] = *(const u32x4*)PJ(proj, tok0 + rr, C_XBC + ch); }
#pragma unroll
    for (int i = 0; i < RPT; ++i) { const int r = rs0 + i;
        float acc[8];
#pragma unroll
        for (int e = 0; e < 8; ++e) acc[e] = bias[e];
#pragma unroll
        for (int j = 0; j < 4; ++j) { const u32x4 v = x[i + j];
#pragma unroll
            for (int e = 0; e < 4; ++e) { acc[2 * e] += w[j][2 * e] * bflo(v[e]); acc[2 * e + 1] += w[j][2 * e + 1] * bfhi(v[e]); } }
        float sc = 1.f;
        if (SCALE) sc = *(const LAS float*)(scl + (r * 4 + (chunk >> 3)) * 4);
        u32x4 o;
#pragma unroll
        for (int e = 0; e < 4; ++e) o[e] = pk2(siluf(acc[2 * e]) * sc, siluf(acc[2 * e + 1]) * sc);
        *(LAS u32x4*)(dst + (r * ldd + chunk * 8) * 2) = o;
    }
}

namespace pg8 {
constexpr int BM = 256, BK = 64, HALF = 128, HTB = HALF * BK * 2, STAGE_BYTES = 8 * HTB, NXCD = 8, WGM = 8;
__device__ __forceinline__ int lds_byte(int r, int c) { const int st = (r >> 4) * 2 + (c >> 5), rr = r & 15, cc = c & 31, ob = rr * 64 + cc * 2; return st * 1024 + (ob ^ (((ob >> 9) & 1) << 5)); }
__device__ __forceinline__ void stage_rc(int b, int& R, int& C) { const int st = b / 1024, sb = b % 1024, swz = sb ^ (((sb >> 9) & 1) << 5); R = (st >> 1) * 16 + swz / 64; C = (st & 1) * 32 + (swz % 64) / 2; }
__device__ __forceinline__ int perm32(int rho) { const int n = rho >> 4, i = rho & 15; return 8 * (i >> 2) + 4 * n + (i & 3); }
struct Unit { int pm, pn; };
struct Gemm { const u16* A; const u16* Bt; int M, N, K, lda, ldb; u16* O; int ldc; int astream, ostream; };
struct StaticOrder {
    int nM, nN, nwg, G, c;
    __device__ void init(int M, int N, int G_, int c_) { nM = M / BM; nN = N / BM; nwg = nM * nN; G = G_; c = c_; }
    __device__ bool next(int i, Unit& u) const {
        const long L = (long)i * G + c; if (L >= nwg) return false;
        int wgid = (int)L; { const int q = nwg / NXCD, r = nwg % NXCD, xcd = wgid % NXCD, off = wgid / NXCD; wgid = (xcd < r ? xcd * (q + 1) : r * (q + 1) + (xcd - r) * q) + off; }
        const int nig = WGM * nN, gid = wgid / nig, fm = gid * WGM, gsz = (nM - fm) < WGM ? (nM - fm) : WGM;
        u.pm = fm + ((wgid % nig) % gsz); u.pn = (wgid % nig) / gsz; return true;
    }
};
__device__ __forceinline__ void epi_bf16(const Gemm& g, const f32x4 (&acc)[2][2][4][2], const Unit& u, int wr, int wc, int fr, int fq) {
    const int row0 = u.pm * BM + wr * 64 + fr, col0 = u.pn * BM + wc * 32 + 8 * fq;
#pragma unroll
    for (int ai = 0; ai < 2; ++ai)
#pragma unroll
        for (int m = 0; m < 4; ++m) { const size_t row = (size_t)(row0 + ai * HALF + m * 16);
            u16* rowp = g.ostream ? g.O + (size_t)(8 * u.pn + wc) * STRM + row * 32 + 8 * fq : g.O + row * g.ldc + col0;
            const size_t bstep = g.ostream ? 4 * STRM : (size_t)HALF;
#pragma unroll
            for (int bj = 0; bj < 2; ++bj) { const f32x4 v0 = acc[ai][bj][m][0], v1 = acc[ai][bj][m][1];
                u32x4 w; w.x = pk2(v0[0], v0[1]); w.y = pk2(v0[2], v0[3]); w.z = pk2(v1[0], v1[1]); w.w = pk2(v1[2], v1[3]);
                *(u32x4*)(rowp + bj * bstep) = w; } }
}
__device__ __forceinline__ void gemm_phase(lds_t lds, const Gemm g, const StaticOrder& S) {
    const int tid = otid(), wid = __builtin_amdgcn_readfirstlane(tid >> 6), lane = tid & 63, wr = wid >> 2, wc = wid & 3, fr = lane & 15, fq = lane >> 4;
    const int K = g.K, nt = K / BK;
    unsigned voffA[2], voffB[2];
#pragma unroll
    for (int i = 0; i < 2; ++i) { int R, C; stage_rc(tid * 16 + i * 8192, R, C); const int Rb = (R & ~31) + perm32(R & 31);
        voffA[i] = g.astream ? (unsigned)((size_t)(C >> 5) * STRM + R * 32 + (C & 31)) * 2u : (unsigned)(R * g.lda + C) * 2u; voffB[i] = (unsigned)(Rb * g.ldb + C) * 2u; }
    const size_t kstep = (size_t)(BK * 2);
    const bool astr = g.astream != 0;
#define PG8_KOFFA(t) (astr ? (size_t)(t) * (STRM * 4) : (size_t)(t) * 128)
    const size_t hstepA = (size_t)HALF * g.lda * 2, hstepB = (size_t)HALF * g.ldb * 2;
    const size_t tstepA = 2 * hstepA, tstepB = 2 * hstepB;
    const unsigned ldsw = (unsigned)wid * 1024u;
    const int aoff = lds_byte(wr * 64 + fr, fq * 8), boff = lds_byte(wc * 32 + fr, fq * 8);
#define PG8_SA(b, h) (((b) * 2 + (h)) * HTB)
#define PG8_SB(b, h) ((4 + (b) * 2 + (h)) * HTB)
#define PG8_STAGE(bufoff, gbase, voff) do { _Pragma("unroll") for (int _i = 0; _i < 2; ++_i) \
        __builtin_amdgcn_global_load_lds((const unsigned*)((const char*)(gbase) + (voff)[_i]), (LAS unsigned*)(lds + (bufoff) + ldsw + _i * 8192), 16, 0, 0); } while (0)
#define PG8_LDA(dst, b, h) do { _Pragma("unroll") for (int m = 0; m < 4; ++m) _Pragma("unroll") for (int k = 0; k < 2; ++k) dst[m][k] = *(const LAS bf16x8*)(lds + PG8_SA(b, h) + aoff + m * 2048 + k * 1024); } while (0)
#define PG8_LDB(dst, b, h) do { _Pragma("unroll") for (int n = 0; n < 2; ++n) _Pragma("unroll") for (int k = 0; k < 2; ++k) dst[n][k] = *(const LAS bf16x8*)(lds + PG8_SB(b, h) + boff + n * 2048 + k * 1024); } while (0)
#define PG8_MMA(ai, bj, At, Bt) do { __builtin_amdgcn_s_setprio(1); _Pragma("unroll") for (int m = 0; m < 4; ++m) _Pragma("unroll") for (int n = 0; n < 2; ++n) _Pragma("unroll") for (int k = 0; k < 2; ++k) \
        acc[ai][bj][m][n] = __builtin_amdgcn_mfma_f32_16x16x32_bf16(Bt[n][k], At[m][k], acc[ai][bj][m][n], 0, 0, 0); __builtin_amdgcn_s_setprio(0); } while (0)
#define PG8_WAIT_V(n) asm volatile("s_waitcnt vmcnt(" #n ")" ::: "memory")
#define PG8_WAIT_L(n) asm volatile("s_waitcnt lgkmcnt(" #n ")" ::: "memory")
#define PG8_BAR __builtin_amdgcn_s_barrier()
#define PG8_SCHED __builtin_amdgcn_sched_barrier(0)
    Unit cur, nxt; int ui = 0;
    if (!S.next(0, cur)) return;
    f32x4 acc[2][2][4][2];
#pragma unroll
    for (int a = 0; a < 2; ++a)
#pragma unroll
        for (int b = 0; b < 2; ++b)
#pragma unroll
            for (int m = 0; m < 4; ++m)
#pragma unroll
                for (int n = 0; n < 2; ++n) acc[a][b][m][n] = (f32x4){0.f, 0.f, 0.f, 0.f};
    bf16x8 At[4][2], B0[2][2], B1[2][2];
    const char* cA = (const char*)g.A + (size_t)cur.pm * tstepA; const char* cB = (const char*)g.Bt + (size_t)cur.pn * tstepB;
    PG8_STAGE(PG8_SB(0, 0), cB, voffB); PG8_STAGE(PG8_SA(0, 0), cA, voffA); PG8_STAGE(PG8_SB(0, 1), cB + hstepB, voffB); PG8_STAGE(PG8_SA(0, 1), cA + hstepA, voffA);
    if (wr == 1) PG8_BAR;
    PG8_WAIT_V(4); PG8_BAR;
    PG8_STAGE(PG8_SB(1, 0), cB + kstep, voffB); PG8_STAGE(PG8_SA(1, 0), cA + PG8_KOFFA(1), voffA); PG8_STAGE(PG8_SB(1, 1), cB + hstepB + kstep, voffB);
    PG8_WAIT_V(6); PG8_BAR;
    for (;;) {
        const bool has_next = S.next(ui + 1, nxt);
        const char* nA = has_next ? (const char*)g.A + (size_t)nxt.pm * tstepA : cA; const char* nB = has_next ? (const char*)g.Bt + (size_t)nxt.pn * tstepB : cB;
        for (int t = 0; t < nt; t += 2) {
            const bool last = (t == nt - 2);
            const char* a1 = cA + PG8_KOFFA(t + 1);
            const char* a2 = last ? nA : cA + PG8_KOFFA(t + 2); const char* b2 = last ? nB : cB + (size_t)(t + 2) * kstep;
            const char* a3 = last ? nA + PG8_KOFFA(1) : cA + PG8_KOFFA(t + 3); const char* b3 = b2 + kstep;
            PG8_LDB(B0, 0, 0); PG8_SCHED; PG8_LDA(At, 0, 0); PG8_STAGE(PG8_SA(1, 1), a1 + hstepA, voffA);
            PG8_WAIT_L(8); PG8_BAR; PG8_WAIT_L(0); PG8_MMA(0, 0, At, B0); PG8_BAR; PG8_SCHED;
            PG8_LDB(B1, 0, 1); PG8_STAGE(PG8_SB(0, 0), b2, voffB);
            PG8_BAR; PG8_WAIT_L(0); PG8_MMA(0, 1, At, B1); PG8_BAR;
            PG8_LDA(At, 0, 1); PG8_STAGE(PG8_SA(0, 0), a2, voffA);
            PG8_BAR; PG8_WAIT_L(0); PG8_MMA(1, 0, At, B0); PG8_BAR; PG8_SCHED;
            PG8_STAGE(PG8_SB(0, 1), b2 + hstepB, voffB);
            PG8_WAIT_V(6); PG8_BAR; PG8_MMA(1, 1, At, B1); PG8_BAR;
            PG8_LDB(B0, 1, 0); PG8_SCHED; PG8_LDA(At, 1, 0); PG8_STAGE(PG8_SA(0, 1), a2 + hstepA, voffA);
            PG8_WAIT_L(8); PG8_BAR; PG8_WAIT_L(0); PG8_MMA(0, 0, At, B0); PG8_BAR; PG8_SCHED;
            PG8_LDB(B1, 1, 1); PG8_STAGE(PG8_SB(1, 0), b3, voffB);
            PG8_BAR; PG8_WAIT_L(0); PG8_MMA(0, 1, At, B1); PG8_BAR;
            PG8_LDA(At, 1, 1); PG8_STAGE(PG8_SA(1, 0), a3, voffA);
            PG8_BAR; PG8_WAIT_L(0); PG8_MMA(1, 0, At, B0); PG8_BAR; PG8_SCHED;
            PG8_STAGE(PG8_SB(1, 1), b3 + hstepB, voffB);
            PG8_WAIT_V(6); PG8_BAR; PG8_MMA(1, 1, At, B1); PG8_BAR;
        }
        epi_bf16(g, acc, cur, wr, wc, fr, fq);
        if (!has_next) break;
#pragma unroll
        for (int a = 0; a < 2; ++a)
#pragma unroll
            for (int b = 0; b < 2; ++b)
#pragma unroll
                for (int m = 0; m < 4; ++m)
#pragma unroll
                    for (int n = 0; n < 2; ++n) acc[a][b][m][n] = (f32x4){0.f, 0.f, 0.f, 0.f};
        cur = nxt; cA = nA; cB = nB; ++ui;
    }
    PG8_WAIT_V(0);
    if (wr == 0) PG8_BAR;
    PG8_BAR;
#undef PG8_KOFFA
#undef PG8_SA
#undef PG8_SB
#undef PG8_STAGE
#undef PG8_LDA
#undef PG8_LDB
#undef PG8_MMA
#undef PG8_WAIT_V
#undef PG8_WAIT_L
#undef PG8_BAR
#undef PG8_SCHED
}
}

__device__ __forceinline__ int win_srccol(int seg) {
    switch (seg) { case 0: return 0; case 1: return 512; case 2: return 1024; case 3: return 2048; case 4: return 2560; case 5: return 3592; case 6: return 4104;
                   case 7: return 4616; case 8: return 5640; case 9: return 1536; case 10: return 3072; case 11: return 5128; default: return 6152; }
}
__device__ __forceinline__ void wt_tile(lds_t lds, const float* src, int src_ld, int scol0, u16* dst, int K, int k0, int n0) {
    const int c = otid() & 63, r8 = otid() >> 6;
#pragma unroll
    for (int i = 0; i < 8; ++i) { const int r = r8 + 8 * i; *(LAS float*)(lds + (r * 65 + c) * 4) = src[(size_t)(k0 + r) * src_ld + scol0 + c]; }
    __syncthreads();
#pragma unroll
    for (int i = 0; i < 8; ++i) { const int nn = r8 + 8 * i; dst[(size_t)(n0 + nn) * K + k0 + c] = f2bf(*(const LAS float*)(lds + (c * 65 + nn) * 4)); }
    __syncthreads();
}
template <bool WIN>
__device__ __forceinline__ void convert_mat(lds_t lds, const float* src, int src_ld, u16* dst, int K, int kshift  , int nunits) {
    const int c = otid() & 63, r8 = otid() >> 6, G = gridDim.x;
    for (int u0 = blockIdx.x; u0 < nunits; u0 += 4 * G) {
        float v[4][8];
#pragma unroll
        for (int q = 0; q < 4; ++q) { const int u = u0 + q * G; const bool ok = u < nunits; const int uu = ok ? u : u0;
            const int kt = uu & ((1 << kshift) - 1), n0 = (uu >> kshift) * 64, k0 = kt * 64;
            const int sc = WIN ? (win_srccol(n0 >> 9) + (n0 & 511)) : n0;
#pragma unroll
            for (int i = 0; i < 8; ++i) v[q][i] = src[(size_t)(k0 + r8 + 8 * i) * src_ld + sc + c]; }
#pragma unroll
        for (int q = 0; q < 4; ++q)
#pragma unroll
            for (int i = 0; i < 8; ++i) *(LAS float*)(lds + q * 16640 + ((r8 + 8 * i) * 65 + c) * 4) = v[q][i];
        __syncthreads();
#pragma unroll
        for (int q = 0; q < 4; ++q) { const int u = u0 + q * G; if (u < nunits) { const int kt = u & ((1 << kshift) - 1), n0 = (u >> kshift) * 64, k0 = kt * 64;
#pragma unroll
            for (int i = 0; i < 8; ++i) { const int nn = r8 + 8 * i; dst[(size_t)(n0 + nn) * K + k0 + c] = f2bf(*(const LAS float*)(lds + q * 16640 + (c * 65 + nn) * 4)); } } }
        __syncthreads();
    }
}
__device__ __forceinline__ void convert_win(lds_t lds, const float* w_in_l, u16* WinT) { convert_mat<true>(lds, w_in_l, DIN, WinT, 1024, 4, 16 * 104); }
__device__ __forceinline__ void convert_wout(lds_t lds, const float* w_out_l, u16* WoutT) { convert_mat<false>(lds, w_out_l, 1024, WoutT, 2048, 5, 32 * 16); }
__device__ __forceinline__ float wave_sum(float v) {
#pragma unroll
    for (int m = 32; m >= 1; m >>= 1) v += __shfl_xor(v, m);
    return v;
}
__device__ __forceinline__ void row_pass(lds_t lds, const float* xin, float* xout, u16* yh, bool has_y, const float* post_g, bool has_next, const float* pre_g, const float* w_in_next, float* dtraw, bool dry) {
    const int tid = otid(), wid = tid >> 6, lane = tid & 63;
    if (has_next) { for (int i = tid; i < 8192; i += NTHR) { const int k = i >> 3, j = i & 7; *(LAS float*)(lds + (j * 1024 + k) * 4) = w_in_next[(size_t)k * DIN + 3584 + j]; } }
    __syncthreads();
    const int stride = gridDim.x * 8;
    int row = blockIdx.x * 8 + wid;
    f32x4 nx[4]; u32x2 ny[4];
#pragma unroll
    for (int i = 0; i < 4; ++i) { nx[i] = (f32x4){0.f, 0.f, 0.f, 0.f}; ny[i] = (u32x2){0u, 0u}; }
    if (row < T_TOK) {
#pragma unroll
        for (int i = 0; i < 4; ++i) { nx[i] = *(const f32x4*)(xin + (size_t)row * DM + i * 256 + lane * 4); if (has_y) ny[i] = *(const u32x2*)(yh + (size_t)row * DM + i * 256 + lane * 4); } }
    for (; row < T_TOK; row += stride) {
        f32x4 xv[4]; u32x2 yw[4];
#pragma unroll
        for (int i = 0; i < 4; ++i) { xv[i] = nx[i]; yw[i] = ny[i]; }
        const int nrow = row + stride;
        if (nrow < T_TOK) {
#pragma unroll
            for (int i = 0; i < 4; ++i) { nx[i] = *(const f32x4*)(xin + (size_t)nrow * DM + i * 256 + lane * 4); if (has_y) ny[i] = *(const u32x2*)(yh + (size_t)nrow * DM + i * 256 + lane * 4); } }
        if (has_y) {
            f32x4 yv[4]; float ss = 0.f;
#pragma unroll
            for (int i = 0; i < 4; ++i) { yv[i] = (f32x4){bflo(yw[i][0]), bfhi(yw[i][0]), bflo(yw[i][1]), bfhi(yw[i][1])}; ss += yv[i][0] * yv[i][0] + yv[i][1] * yv[i][1] + yv[i][2] * yv[i][2] + yv[i][3] * yv[i][3]; }
            ss = wave_sum(ss); const float r1 = rsqrtf(ss * (1.f / 1024.f) + EPS);
#pragma unroll
            for (int i = 0; i < 4; ++i) { const f32x4 g = *(const f32x4*)(post_g + i * 256 + lane * 4); xv[i] += yv[i] * r1 * g; if (!dry) *(f32x4*)(xout + (size_t)row * DM + i * 256 + lane * 4) = xv[i]; }
        }
        if (has_next) {
            float ss = 0.f;
#pragma unroll
            for (int i = 0; i < 4; ++i) ss += xv[i][0] * xv[i][0] + xv[i][1] * xv[i][1] + xv[i][2] * xv[i][2] + xv[i][3] * xv[i][3];
            ss = wave_sum(ss); const float r2 = rsqrtf(ss * (1.f / 1024.f) + EPS);
            float d[8];
#pragma unroll
            for (int j = 0; j < 8; ++j) d[j] = 0.f;
#pragma unroll
            for (int i = 0; i < 4; ++i) { const f32x4 g = *(const f32x4*)(pre_g + i * 256 + lane * 4); const f32x4 h = xv[i] * r2 * g;
                u32x2 w; w[0] = pk2(h[0], h[1]); w[1] = pk2(h[2], h[3]); if (!dry) *(u32x2*)(yh + (size_t)row * DM + i * 256 + lane * 4) = w;
#pragma unroll
                for (int j = 0; j < 8; ++j) { const f32x4 wv = *(const LAS f32x4*)(lds + (j * 1024 + i * 256 + lane * 4) * 4); d[j] += h[0] * wv[0] + h[1] * wv[1] + h[2] * wv[2] + h[3] * wv[3]; } }
            const bool b5 = (lane & 32) != 0, b4 = (lane & 16) != 0, b3 = (lane & 8) != 0;
            float e[4], f[2];
#pragma unroll
            for (int j = 0; j < 4; ++j) { const float snd = b5 ? d[j] : d[j + 4], kp = b5 ? d[j + 4] : d[j]; e[j] = kp + __shfl_xor(snd, 32); }
#pragma unroll
            for (int j = 0; j < 2; ++j) { const float snd = b4 ? e[j] : e[j + 2], kp = b4 ? e[j + 2] : e[j]; f[j] = kp + __shfl_xor(snd, 16); }
            float gsum; { const float snd = b3 ? f[0] : f[1], kp = b3 ? f[1] : f[0]; gsum = kp + __shfl_xor(snd, 8); }
            gsum += __shfl_xor(gsum, 4); gsum += __shfl_xor(gsum, 2); gsum += __shfl_xor(gsum, 1);
            if ((lane & 7) == 0 && !dry) dtraw[(size_t)row * 8 + (b5 ? 4 : 0) + (b4 ? 2 : 0) + (b3 ? 1 : 0)] = gsum;
        }
    }
    __syncthreads();
}

__device__ __forceinline__ void phase_prep(lds_t lds, const Params& p) {
    u16* WinT = (u16*)(p.ws + WS_WIN); u16* WoutT = (u16*)(p.ws + WS_WOUT);
    u16* memn = (u16*)p.out; u16* WkvT = (u16*)p.out + 2 * 1024 * 1024;
    float* rc = (float*)(p.ws + WS_ROPE); float* rs = rc + SEQ * 64;
    convert_win(lds, p.w_in, WinT);
    convert_wout(lds, p.w_out, WoutT);
    convert_mat<false>(lds, p.w_mem_kv, 1024, WkvT, 1024, 4, 256);
    convert_mat<false>(lds, p.w_mem_kv + (size_t)1024 * 1024, 1024, WkvT + (size_t)1024 * 1024, 1024, 4, 256);
    for (int i = blockIdx.x * NTHR + otid(); i < SEQ * 64; i += gridDim.x * NTHR) { const int pos = i >> 6, f = i & 63;
        const float inv = exp2f(-(float)f * 0.20762050593046015f);
        const float ang = (float)pos * inv;
        const float kq = rintf(ang * 0.15915494309189535f);
        float rf = fmaf(-kq, 6.2831854820251465f, ang); rf = fmaf(-kq, -1.7484555e-7f, rf);
        rc[i] = __cosf(rf); rs[i] = __sinf(rf); }
    { const int wid = otid() >> 6, lane = otid() & 63;
      for (int row = blockIdx.x * 8 + wid; row < 2048; row += gridDim.x * 8) { const int l = row >> 10, r = row & 1023;
          f32x4 xv[4]; float ss = 0.f;
#pragma unroll
          for (int i = 0; i < 4; ++i) { xv[i] = *(const f32x4*)(p.mem + (size_t)r * DM + i * 256 + lane * 4); ss += xv[i][0] * xv[i][0] + xv[i][1] * xv[i][1] + xv[i][2] * xv[i][2] + xv[i][3] * xv[i][3]; }
          ss = wave_sum(ss); const float r2 = rsqrtf(ss * (1.f / 1024.f) + EPS);
#pragma unroll
          for (int i = 0; i < 4; ++i) { const f32x4 g = *(const f32x4*)(p.mem_norm_g + l * 1024 + i * 256 + lane * 4); const f32x4 h = xv[i] * r2 * g;
              u32x2 w; w[0] = pk2(h[0], h[1]); w[1] = pk2(h[2], h[3]); *(u32x2*)(memn + (size_t)row * DM + i * 256 + lane * 4) = w; } } }
    row_pass(lds, p.x, nullptr, (u16*)(p.ws + WS_ST), false, nullptr, true, p.pre_g, p.w_in, (float*)(p.ws + WS_DT), false);
}

__device__ __forceinline__ float ret_log2g(int h) { return log2f(1.f - exp2f(-5.f - (float)h)); }

__device__ __forceinline__ bf16x8 pack8(const f32x4& a, const f32x4& b) {
    u32x4 w; w[0] = pk2(a[0], a[1]); w[1] = pk2(a[2], a[3]); w[2] = pk2(b[0], b[1]); w[3] = pk2(b[2], b[3]); return __builtin_bit_cast(bf16x8, w);
}
__device__ __forceinline__ bf16x8 frag_vtl(lds_t base, int ld, int e0, int k2, int fr, int fq) {
    lds_t p = base + ((32 * k2 + 4 * fq + (fr >> 2)) * ld + e0 + 4 * (fr & 3)) * 2;
    const s16x4 lo = trrd(p), hi = trrd(p + 16 * ld * 2);
    return (bf16x8){lo[0], lo[1], lo[2], lo[3], hi[0], hi[1], hi[2], hi[3]};
}
__device__ __forceinline__ bf16x8 frag_vt(lds_t base, int e0, int k2, int fr, int fq) {
    lds_t p = base + ((32 * k2 + 4 * fq + (fr >> 2)) * 136 + e0 + 4 * (fr & 3)) * 2;
    const s16x4 lo = trrd(p), hi = trrd(p + 16 * 136 * 2);
    return (bf16x8){lo[0], lo[1], lo[2], lo[3], hi[0], hi[1], hi[2], hi[3]};
}
__device__ __forceinline__ void sb_item(lds_t lds, u16* proj, int it, bool dry) {
    const int tid = otid(), wid = tid >> 6, lane = tid & 63, fr = lane & 15, fq = lane >> 4;
    const int qb = it & 63, h = (it >> 6) & 3, b = it >> 8;
    const size_t tok0 = (size_t)b * SEQ + qb * 128;
    lds_t Ks = lds, Vs = lds + 17408, red = lds + 35840;
    const int tpos = qb * 128 + 16 * wid + fr;
    bf16x8 qf[4];
    {
#pragma unroll
      for (int ks = 0; ks < 4; ++ks) qf[ks] = __builtin_bit_cast(bf16x8, *(const u32x4*)PJ(proj, tok0 + 16 * wid + fr, C_SQ + h * 128 + 8 * fq + 32 * ks)); }
    const int sr = (tid >> 2) & 31, sc = ((tid >> 7) << 2) | (tid & 3);
    u32x4 kr0, kr1, vr0, vr1;
    { const size_t t0 = (size_t)b * SEQ + (2 * qb + 1) * 64 + sr; const u16* kp = PJ(proj, t0, C_SK + h * 128 + sc * 8); const size_t vo = (size_t)((C_SV - C_SK) >> 5) * STRM;
      kr0 = *(const u32x4*)(kp); kr1 = *(const u32x4*)(kp + 32 * 32); vr0 = *(const u32x4*)(kp + vo); vr1 = *(const u32x4*)(kp + vo + 32 * 32); }
    __syncthreads();
    *(LAS u32x4*)(Ks + (sr * 136 + sc * 8) * 2) = kr0; *(LAS u32x4*)(Ks + ((sr + 32) * 136 + sc * 8) * 2) = kr1;
    *(LAS u32x4*)(Vs + (sr * 144 + sc * 8) * 2) = vr0; *(LAS u32x4*)(Vs + ((sr + 32) * 144 + sc * 8) * 2) = vr1;
    __syncthreads();
    f32x4 O[8], carry = (f32x4){0.f, 0.f, 0.f, 0.f};
#pragma unroll
    for (int n = 0; n < 8; ++n) O[n] = (f32x4){0.f, 0.f, 0.f, 0.f};
    const bf16x8 ones = (bf16x8){0x3F80, 0x3F80, 0x3F80, 0x3F80, 0x3F80, 0x3F80, 0x3F80, 0x3F80};
    bf16x8 U00, U10;
#pragma unroll
    for (int jj = 0; jj < 8; ++jj) { const int j = (jj < 4 ? 4 * fq + jj : 16 + 4 * fq + jj - 4); U00[jj] = (j > fr) ? (short)0x3F80 : (short)0; U10[jj] = (j > 16 + fr) ? (short)0x3F80 : (short)0; }
    float wmax = 0.f;
    for (int kb = 2 * qb + 1; kb >= 0; --kb) {
        if (kb > 0) { const size_t t0 = (size_t)b * SEQ + (kb - 1) * 64 + sr; const u16* kp = PJ(proj, t0, C_SK + h * 128 + sc * 8); const size_t vo = (size_t)((C_SV - C_SK) >> 5) * STRM;
            kr0 = *(const u32x4*)(kp); kr1 = *(const u32x4*)(kp + 32 * 32); vr0 = *(const u32x4*)(kp + vo); vr1 = *(const u32x4*)(kp + vo + 32 * 32); }
        const bool active = (kb * 64 < qb * 128 + 16 * wid + 15) && !(wmax < -110.f);
        if (active) {
        f32x4 S[4];
        { bf16x8 kf[16];
#pragma unroll
          for (int u = 0; u < 16; ++u) kf[u] = frag_row(Ks, 136, 16 * (u & 3), 32 * (u >> 2), fr, fq);
          __builtin_amdgcn_sched_barrier(0);
#pragma unroll
          for (int n = 0; n < 4; ++n) S[n] = (f32x4){0.f, 0.f, 0.f, 0.f};
#pragma unroll
          for (int ks = 0; ks < 4; ++ks)
#pragma unroll
              for (int n = 0; n < 4; ++n) S[n] = MFMA16(kf[4 * ks + n], qf[ks], S[n]);
          __builtin_amdgcn_sched_barrier(0); }
        bf16x8 vf[16];
#pragma unroll
        for (int u = 0; u < 16; ++u) vf[u] = frag_vtl(Vs, 144, 16 * (u & 7), u >> 3, fr, fq);
        __builtin_amdgcn_sched_barrier(0);
        f32x4 E[4], Lh[4], Ll[4];
#pragma unroll
        for (int n = 0; n < 4; ++n) { const int sbase = kb * 64 + 16 * n + 4 * fq;
#pragma unroll
            for (int r = 0; r < 4; ++r) { const float xx = S[n][r] * 0.08838834764831845f; const float lg = __logf(1.f + __expf(-fabsf(xx)));
                const float L = -fmaxf(xx, 0.f) - lg; E[n][r] = fminf(xx, 0.f) - lg;
                const float Lm = (sbase + r < tpos) ? L : 0.f; const float hi = bf2f(f2bf(Lm));
                Lh[n][r] = hi; Ll[n][r] = Lm - hi; } }
        const bf16x8 bh0 = pack8(Lh[0], Lh[1]), bh1 = pack8(Lh[2], Lh[3]), bl0 = pack8(Ll[0], Ll[1]), bl1 = pack8(Ll[2], Ll[3]);
        f32x4 tail[4];
#pragma unroll
        for (int n = 0; n < 4; ++n) tail[n] = carry;
        tail[0] = MFMA16(U00, bh0, tail[0]); tail[0] = MFMA16(U00, bl0, tail[0]); tail[0] = MFMA16(ones, bh1, tail[0]); tail[0] = MFMA16(ones, bl1, tail[0]);
        tail[1] = MFMA16(U10, bh0, tail[1]); tail[1] = MFMA16(U10, bl0, tail[1]); tail[1] = MFMA16(ones, bh1, tail[1]); tail[1] = MFMA16(ones, bl1, tail[1]);
        tail[2] = MFMA16(U00, bh1, tail[2]); tail[2] = MFMA16(U00, bl1, tail[2]);
        tail[3] = MFMA16(U10, bh1, tail[3]); tail[3] = MFMA16(U10, bl1, tail[3]);
        carry = MFMA16(ones, bh0, carry); carry = MFMA16(ones, bl0, carry); carry = MFMA16(ones, bh1, carry); carry = MFMA16(ones, bl1, carry);
        f32x4 W[4];
#pragma unroll
        for (int n = 0; n < 4; ++n) { const int sbase = kb * 64 + 16 * n + 4 * fq;
#pragma unroll
            for (int r = 0; r < 4; ++r) W[n][r] = (sbase + r < tpos) ? __expf(E[n][r] + tail[n][r]) : 0.f; }
        const bf16x8 bw0 = pack8(W[0], W[1]), bw1 = pack8(W[2], W[3]);
#pragma unroll
        for (int n = 0; n < 8; ++n) O[n] = MFMA16(vf[n], bw0, O[n]);
#pragma unroll
        for (int n = 0; n < 8; ++n) O[n] = MFMA16(vf[8 + n], bw1, O[n]);
        { float m = carry[0]; m = fmaxf(m, __shfl_xor(m, 1)); m = fmaxf(m, __shfl_xor(m, 2)); m = fmaxf(m, __shfl_xor(m, 4)); m = fmaxf(m, __shfl_xor(m, 8)); wmax = m; }
        }
        if (lane == 0) *(LAS float*)(red + wid * 4) = wmax;
        __syncthreads();
        float bm = *(const LAS float*)(red);
#pragma unroll
        for (int w = 1; w < 8; ++w) bm = fmaxf(bm, *(const LAS float*)(red + w * 4));
        if (bm < -110.f || kb == 0) break;
        *(LAS u32x4*)(Ks + (sr * 136 + sc * 8) * 2) = kr0; *(LAS u32x4*)(Ks + ((sr + 32) * 136 + sc * 8) * 2) = kr1;
        *(LAS u32x4*)(Vs + (sr * 144 + sc * 8) * 2) = vr0; *(LAS u32x4*)(Vs + ((sr + 32) * 144 + sc * 8) * 2) = vr1;
        __syncthreads();
    }
#pragma unroll
    for (int n = 0; n < 8; ++n) { u16* gp = PJ(proj, tok0 + 16 * wid + fr, C_SG + h * 128 + 4 * fq + 16 * n); const u32x2 gv = *(const u32x2*)(gp); u32x2 o;
        o[0] = pk2(O[n][0] * siluf(bflo(gv[0])), O[n][1] * siluf(bfhi(gv[0]))); o[1] = pk2(O[n][2] * siluf(bflo(gv[1])), O[n][3] * siluf(bfhi(gv[1])));
        if (!dry) *(u32x2*)(gp) = o; }
}

__device__ __forceinline__ void mem_group(lds_t lds, u16* proj, const u16* memkv, bool dry) {
    const int tid = otid(), wid = tid >> 6, lane = tid & 63, fr = lane & 15, fq = lane >> 4;
    lds_t Km = lds, Vm = lds + 69632;
    int cur_bh = -1;
    for (int idx = blockIdx.x * 4; idx < 1024; idx += gridDim.x * 4) {
        const int bh = idx >> 6, b = bh >> 2, h = bh & 3;
        if (bh != cur_bh) { __syncthreads();
            copy_tile(Km, 136, memkv + (size_t)b * 256 * 1024 + h * 128, 1024, 256, 4);
            copy_tile(Vm, 144, memkv + (size_t)b * 256 * 1024 + 512 + h * 128, 1024, 256, 4);
            __syncthreads(); cur_bh = bh; }
        u32x4 qn[4];
        {
#pragma unroll
          for (int ks = 0; ks < 4; ++ks) qn[ks] = *(const u32x4*)PJ(proj, (size_t)b * SEQ + (idx & 63) * 128 + 16 * wid + fr, C_MQ + h * 128 + 8 * fq + 32 * ks); }
#pragma unroll 1
        for (int j = 0; j < 4; ++j) { const int tile = (idx + j) & 63;
            const size_t tok = (size_t)b * SEQ + tile * 128 + 16 * wid + fr;
            bf16x8 qf[4];
#pragma unroll
            for (int ks = 0; ks < 4; ++ks) qf[ks] = __builtin_bit_cast(bf16x8, qn[ks]);
            if (j < 3) {
#pragma unroll
                for (int ks = 0; ks < 4; ++ks) qn[ks] = *(const u32x4*)PJ(proj, tok + 128, C_MQ + h * 128 + 8 * fq + 32 * ks); }
            u32x2 gv[8];
#pragma unroll
            for (int n = 0; n < 8; ++n) gv[n] = *(const u32x2*)PJ(proj, tok, C_MG + h * 128 + 4 * fq + 16 * n);
            f32x4 S[16];
            { bf16x8 kf[2][8];
#pragma unroll
              for (int u = 0; u < 8; ++u) kf[0][u] = frag_row(Km, 136, 16 * (u >> 2), 32 * (u & 3), fr, fq);
#pragma unroll
              for (int np = 0; np < 8; ++np) {
                  if (np + 1 < 8) {
#pragma unroll
                      for (int u = 0; u < 8; ++u) kf[(np + 1) & 1][u] = frag_row(Km, 136, 16 * (2 * np + 2 + (u >> 2)), 32 * (u & 3), fr, fq); }
                  __builtin_amdgcn_sched_barrier(0);
                  S[2 * np] = (f32x4){0.f, 0.f, 0.f, 0.f}; S[2 * np + 1] = (f32x4){0.f, 0.f, 0.f, 0.f};
#pragma unroll
                  for (int ks = 0; ks < 4; ++ks) { S[2 * np] = MFMA16(kf[np & 1][ks], qf[ks], S[2 * np]); S[2 * np + 1] = MFMA16(kf[np & 1][4 + ks], qf[ks], S[2 * np + 1]); }
                  __builtin_amdgcn_sched_barrier(0); } }
            float m = S[0][0];
#pragma unroll
            for (int n = 0; n < 16; ++n)
#pragma unroll
                for (int r = 0; r < 4; ++r) m = fmaxf(m, S[n][r]);
            m = fmaxf(m, __shfl_xor(m, 16)); m = fmaxf(m, __shfl_xor(m, 32));
            float s = 0.f;
#pragma unroll
            for (int n = 0; n < 16; ++n)
#pragma unroll
                for (int r = 0; r < 4; ++r) { const float e = __expf((S[n][r] - m) * 0.08838834764831845f); S[n][r] = e; s += e; }
            s += __shfl_xor(s, 16); s += __shfl_xor(s, 32);
            const float inv = 1.f / s;
            f32x4 O[8];
#pragma unroll
            for (int n = 0; n < 8; ++n) O[n] = (f32x4){0.f, 0.f, 0.f, 0.f};
            { bf16x8 af[2][8];
#pragma unroll
              for (int n = 0; n < 8; ++n) af[0][n] = frag_vtl(Vm, 144, 16 * n, 0, fr, fq);
#pragma unroll
              for (int k2 = 0; k2 < 8; ++k2) { const bf16x8 bp = pack8(S[2 * k2], S[2 * k2 + 1]);
                  if (k2 + 1 < 8) {
#pragma unroll
                      for (int n = 0; n < 8; ++n) af[(k2 + 1) & 1][n] = frag_vtl(Vm, 144, 16 * n, k2 + 1, fr, fq); }
                  __builtin_amdgcn_sched_barrier(0);
#pragma unroll
                  for (int n = 0; n < 8; ++n) O[n] = MFMA16(af[k2 & 1][n], bp, O[n]);
                  __builtin_amdgcn_sched_barrier(0); } }
#pragma unroll
            for (int n = 0; n < 8; ++n) { u16* gp = PJ(proj, tok, C_MG + h * 128 + 4 * fq + 16 * n); u32x2 o;
                o[0] = pk2(O[n][0] * inv * siluf(bflo(gv[n][0])), O[n][1] * inv * siluf(bfhi(gv[n][0]))); o[1] = pk2(O[n][2] * inv * siluf(bflo(gv[n][1])), O[n][3] * inv * siluf(bfhi(gv[n][1])));
                if (!dry) *(u32x2*)(gp) = o; }
        }
    }
    __syncthreads();
}

__device__ __forceinline__ void ret_state_item(lds_t lds, const u16* proj, u16* retS, const float* rc, const float* rs, int it) {
    const int tid = otid(), wid = tid >> 6, lane = tid & 63, fr = lane & 15, fq = lane >> 4, wr = wid >> 1, wc = wid & 1;
    const int h = it & 3, bc = it >> 2, c = bc & 63, b = bc >> 6;
    const size_t tok0 = (size_t)b * SEQ + c * 128;
    lds_t KZ = lds, Vs = lds + 34816;
    __syncthreads();
    rope_tile(KZ, proj, tok0, C_RK + h * 128, rc, rs, c * 128, 0.08838834764831845f, ret_log2g(h));
    copy_tile_pj(Vs, 136, proj, tok0, C_RV + h * 128);
    __syncthreads();
    f32x4 acc[2][4];
#pragma unroll
    for (int m = 0; m < 2; ++m)
#pragma unroll
        for (int n = 0; n < 4; ++n) acc[m][n] = (f32x4){0.f, 0.f, 0.f, 0.f};
#pragma unroll
    for (int ks = 0; ks < 4; ++ks) { bf16x8 a[2], bq[4];
#pragma unroll
        for (int m = 0; m < 2; ++m) a[m] = frag_tr(Vs, 136, 32 * wr + 16 * m, 32 * ks, fr, fq);
#pragma unroll
        for (int n = 0; n < 4; ++n) bq[n] = frag_tr(KZ, 136, 64 * wc + 16 * n, 32 * ks, fr, fq);
#pragma unroll
        for (int m = 0; m < 2; ++m)
#pragma unroll
            for (int n = 0; n < 4; ++n) acc[m][n] = MFMA16(a[m], bq[n], acc[m][n]); }
    u16* dst = retS + (size_t)it * 16384;
#pragma unroll
    for (int m = 0; m < 2; ++m)
#pragma unroll
        for (int n = 0; n < 4; ++n)
#pragma unroll
            for (int r = 0; r < 4; ++r) dst[(32 * wr + 16 * m + 4 * fq + r) * 128 + 64 * wc + 16 * n + fr] = f2bf(acc[m][n][r]);
}

__device__ __forceinline__ void ssd_dt(lds_t acs, lds_t dlt, const float* dtraw, const float* dt_bias, const float* a_log, size_t tok0, int g) {
    const int tid = otid();
    { const int t = tid >> 2, hh = tid & 3, h = 4 * g + hh;
      const float dr = dtraw[(tok0 + t) * 8 + h] + dt_bias[h];
      const float delta = dr > 20.f ? dr : log1pf(__expf(dr));
      *(LAS float*)(dlt + tid * 4) = delta; *(LAS float*)(acs + tid * 4) = -delta * __expf(a_log[h]); }
    __syncthreads();
    if (tid < 256) { const int hh = tid >> 6, ln = tid & 63;
        const float v0 = *(const LAS float*)(acs + ((2 * ln) * 4 + hh) * 4), v1 = *(const LAS float*)(acs + ((2 * ln + 1) * 4 + hh) * 4);
        float sc = v0 + v1;
#pragma unroll
        for (int d = 1; d < 64; d <<= 1) { const float o = __shfl_up(sc, d); if (ln >= d) sc += o; }
        *(LAS float*)(acs + ((2 * ln) * 4 + hh) * 4) = sc - v1; *(LAS float*)(acs + ((2 * ln + 1) * 4 + hh) * 4) = sc; }
    __syncthreads();
}

__device__ __forceinline__ void ssd_state_item(lds_t lds, const u16* proj, u16* ssdS, float* cdec, const float* dtraw, const float* cw, const float* cb, const float* dt_bias, const float* a_log, int it) {
    const int tid = otid(), wid = tid >> 6, lane = tid & 63, fr = lane & 15, fq = lane >> 4, wr = wid >> 1, wc = wid & 1;
    const int g = it & 1, bc = it >> 1, c = bc & 63, b = bc >> 6;
    const size_t tok0 = (size_t)b * SEQ + c * 128;
    lds_t Bm = lds, XW = lds + 34816, acs = lds + 102400, dlt = lds + 104448, scl = lds + 106496;
    __syncthreads();
    ssd_dt(acs, dlt, dtraw, dt_bias, a_log, tok0, g);
    { const int hh = tid & 3; const float al = *(const LAS float*)(acs + (127 * 4 + hh) * 4);
      *(LAS float*)(scl + tid * 4) = *(const LAS float*)(dlt + tid * 4) * __expf(al - *(const LAS float*)(acs + tid * 4));
      if (tid < 4) cdec[(size_t)bc * 8 + 4 * g + tid] = __expf(al); }
    __syncthreads();
    conv_tile<16, false>(Bm, 136, proj, tok0, c * 128, 512 + g * 128, cw, cb, scl);
    conv_tile<32, true>(XW, 264, proj, tok0, c * 128, g * 256, cw, cb, scl);
    __syncthreads();
    u16* dst = ssdS + ((size_t)bc * 8 + 4 * g + wr) * 8192;
#pragma unroll 1
    for (int nh = 0; nh < 2; ++nh) {
        f32x4 acc[4][2];
#pragma unroll
        for (int m = 0; m < 4; ++m)
#pragma unroll
            for (int n = 0; n < 2; ++n) acc[m][n] = (f32x4){0.f, 0.f, 0.f, 0.f};
#pragma unroll
        for (int ks = 0; ks < 4; ++ks) { bf16x8 a[4], bq[2];
#pragma unroll
            for (int m = 0; m < 4; ++m) a[m] = frag_tr(XW, 264, 64 * wr + 16 * m, 32 * ks, fr, fq);
#pragma unroll
            for (int n = 0; n < 2; ++n) bq[n] = frag_tr(Bm, 136, 64 * wc + 32 * nh + 16 * n, 32 * ks, fr, fq);
#pragma unroll
            for (int m = 0; m < 4; ++m)
#pragma unroll
                for (int n = 0; n < 2; ++n) acc[m][n] = MFMA16(a[m], bq[n], acc[m][n]); }
#pragma unroll
        for (int m = 0; m < 4; ++m)
#pragma unroll
            for (int n = 0; n < 2; ++n)
#pragma unroll
                for (int r = 0; r < 4; ++r) dst[(16 * m + 4 * fq + r) * 128 + 64 * wc + 32 * nh + 16 * n + fr] = f2bf(acc[m][n][r]);
    }
}

__device__ __forceinline__ void scan_phase(u16* retS, u16* ssdS, const float* cdec, bool dry) {
    const int tid = otid();
    if (tid >= 256) return;
    for (int q = blockIdx.x * 256 + tid; q < 65536; q += gridDim.x * 256) {
        float st[8];
#pragma unroll
        for (int e = 0; e < 8; ++e) st[e] = 0.f;
        u16* p; const float* dp = nullptr; float dec0 = 0.f;
        if (q < 32768) { const int bh = q >> 11, e8 = q & 2047, b = bh >> 2, h = bh & 3;
            dec0 = exp2f(128.f * ret_log2g(h));
            p = retS + ((size_t)(b * 64) * 4 + h) * 16384 + e8 * 8;
        } else { const int q2 = q - 32768, bh = q2 >> 10, e8 = q2 & 1023, b = bh >> 3, h = bh & 7;
            p = ssdS + ((size_t)(b * 64) * 8 + h) * 8192 + e8 * 8; dp = cdec + (size_t)(b * 64) * 8 + h; }
#pragma unroll 16
        for (int c = 0; c < 64; ++c) { u32x4* pp = (u32x4*)(p + (size_t)c * 65536); const u32x4 v = *pp; const float dec = dp ? dp[c * 8] : dec0;
            u32x4 o;
#pragma unroll
            for (int e = 0; e < 4; ++e) o[e] = pk2(st[2 * e], st[2 * e + 1]);
            *pp = o;
#pragma unroll
            for (int e = 0; e < 4; ++e) { st[2 * e] = dec * st[2 * e] + bflo(v[e]); st[2 * e + 1] = dec * st[2 * e + 1] + bfhi(v[e]); } }
    }
}

__device__ __forceinline__ void ret_out_item(lds_t lds, u16* proj, const u16* retS, const float* rc, const float* rs, int it, bool dry) {
    const int tid = otid(), wid = tid >> 6, lane = tid & 63, fr = lane & 15, fq = lane >> 4, wr = wid >> 1, wc = wid & 1;
    const int h = it & 3, bc = it >> 2, c = bc & 63, b = bc >> 6;
    const size_t tok0 = (size_t)b * SEQ + c * 128;
    const float l2g = ret_log2g(h);
    lds_t Qs = lds, Ks = lds + 34816, Vs = lds + 69632, Rs = lds + 104448, Ys = lds;
    __syncthreads();
    rope_tile(Qs, proj, tok0, C_RQ + h * 128, rc, rs, c * 128, 1.f, 0.f);
    rope_tile(Ks, proj, tok0, C_RK + h * 128, rc, rs, c * 128, 0.08838834764831845f, 0.f);
    copy_tile_pj(Vs, 136, proj, tok0, C_RV + h * 128);
    copy_tile(Rs, 136, retS + (size_t)it * 16384, 128, 128, 4);
    __syncthreads();
    f32x4 a1[2][4], a2[2][4];
#pragma unroll
    for (int m = 0; m < 2; ++m)
#pragma unroll
        for (int n = 0; n < 4; ++n) { a1[m][n] = (f32x4){0.f, 0.f, 0.f, 0.f}; a2[m][n] = (f32x4){0.f, 0.f, 0.f, 0.f}; }
    { bf16x8 fb[2][10];
#pragma unroll
      for (int u = 0; u < 10; ++u) fb[0][u] = (u < 2) ? frag_row(Qs, 136, 32 * wr + 16 * u, 0, fr, fq) : (u < 6) ? frag_row(Ks, 136, 64 * wc + 16 * (u - 2), 0, fr, fq) : frag_row(Rs, 136, 64 * wc + 16 * (u - 6), 0, fr, fq);
#pragma unroll
      for (int ks = 0; ks < 4; ++ks) {
          if (ks + 1 < 4) {
#pragma unroll
              for (int u = 0; u < 10; ++u) fb[(ks + 1) & 1][u] = (u < 2) ? frag_row(Qs, 136, 32 * wr + 16 * u, 32 * (ks + 1), fr, fq) : (u < 6) ? frag_row(Ks, 136, 64 * wc + 16 * (u - 2), 32 * (ks + 1), fr, fq) : frag_row(Rs, 136, 64 * wc + 16 * (u - 6), 32 * (ks + 1), fr, fq); }
          __builtin_amdgcn_sched_barrier(0);
#pragma unroll
          for (int n = 0; n < 4; ++n)
#pragma unroll
              for (int m = 0; m < 2; ++m) { a1[m][n] = MFMA16(fb[ks & 1][m], fb[ks & 1][2 + n], a1[m][n]); a2[m][n] = MFMA16(fb[ks & 1][m], fb[ks & 1][6 + n], a2[m][n]); }
          __builtin_amdgcn_sched_barrier(0); } }
    __syncthreads();
#pragma unroll
    for (int m = 0; m < 2; ++m)
#pragma unroll
        for (int n = 0; n < 4; ++n)
#pragma unroll
            for (int r = 0; r < 4; ++r) { const int l = 32 * wr + 16 * m + 4 * fq + r, mm = 64 * wc + 16 * n + fr;
                const float pv = (l >= mm) ? a1[m][n][r] * exp2f(l2g * (float)(l - mm)) : 0.f;
                *(LAS u16*)(Ks + (l * 136 + mm) * 2) = f2bf(pv); }
    __syncthreads();
#pragma unroll
    for (int m = 0; m < 2; ++m)
#pragma unroll
        for (int n = 0; n < 4; ++n) a1[m][n] = (f32x4){0.f, 0.f, 0.f, 0.f};
    { bf16x8 fb[2][6];
#pragma unroll
      for (int u = 0; u < 6; ++u) fb[0][u] = (u < 2) ? frag_row(Ks, 136, 32 * wr + 16 * u, 0, fr, fq) : frag_tr(Vs, 136, 64 * wc + 16 * (u - 2), 0, fr, fq);
#pragma unroll
      for (int ks = 0; ks < 4; ++ks) {
          if (ks + 1 < 4) {
#pragma unroll
              for (int u = 0; u < 6; ++u) fb[(ks + 1) & 1][u] = (u < 2) ? frag_row(Ks, 136, 32 * wr + 16 * u, 32 * (ks + 1), fr, fq) : frag_tr(Vs, 136, 64 * wc + 16 * (u - 2), 32 * (ks + 1), fr, fq); }
          __builtin_amdgcn_sched_barrier(0);
#pragma unroll
          for (int n = 0; n < 4; ++n)
#pragma unroll
              for (int m = 0; m < 2; ++m) a1[m][n] = MFMA16(fb[ks & 1][m], fb[ks & 1][2 + n], a1[m][n]);
          __builtin_amdgcn_sched_barrier(0); } }
    __syncthreads();
#pragma unroll
    for (int m = 0; m < 2; ++m)
#pragma unroll
        for (int r = 0; r < 4; ++r) { const int l = 32 * wr + 16 * m + 4 * fq + r; const float xi = exp2f(l2g * (float)(l + 1));
#pragma unroll
            for (int n = 0; n < 4; ++n) *(LAS float*)(Ys + (l * 132 + 64 * wc + 16 * n + fr) * 4) = a1[m][n][r] + xi * a2[m][n][r]; }
    __syncthreads();
    { const int r = tid >> 2, q4 = tid & 3; float v[32]; float s = 0.f;
#pragma unroll
      for (int i = 0; i < 8; ++i) { const f32x4 t = *(const LAS f32x4*)(Ys + (r * 132 + q4 * 32 + i * 4) * 4); v[4 * i] = t[0]; v[4 * i + 1] = t[1]; v[4 * i + 2] = t[2]; v[4 * i + 3] = t[3]; s += t[0] + t[1] + t[2] + t[3]; }
      s += __shfl_xor(s, 1); s += __shfl_xor(s, 2); const float mu = s * (1.f / 128.f);
      float q = 0.f;
#pragma unroll
      for (int i = 0; i < 32; ++i) { v[i] -= mu; q += v[i] * v[i]; }
      q += __shfl_xor(q, 1); q += __shfl_xor(q, 2); const float rstd = rsqrtf(q * (1.f / 128.f) + EPS);
      u16* gp = PJ(proj, tok0 + r, C_RG + h * 128 + q4 * 32);
#pragma unroll
      for (int i = 0; i < 4; ++i) { const u32x4 gv = *(const u32x4*)(gp + i * 8); u32x4 o;
#pragma unroll
          for (int e = 0; e < 4; ++e) o[e] = pk2(v[8 * i + 2 * e] * rstd * siluf(bflo(gv[e])), v[8 * i + 2 * e + 1] * rstd * siluf(bfhi(gv[e])));
          if (!dry) *(u32x4*)(gp + i * 8) = o; } }
}

__device__ __forceinline__ bf16x8 frag_vt_ld(lds_t base, int ld, int e0, int k2, int fr, int fq) {
    lds_t p = base + ((32 * k2 + 4 * fq + (fr >> 2)) * ld + e0 + 4 * (fr & 3)) * 2;
    const s16x4 lo = trrd(p), hi = trrd(p + 16 * ld * 2);
    return (bf16x8){lo[0], lo[1], lo[2], lo[3], hi[0], hi[1], hi[2], hi[3]};
}
__device__ __forceinline__ void ssd_out_item(lds_t lds, u16* proj, const u16* ssdS, const float* dtraw, const float* cw, const float* cb, const float* dt_bias, const float* a_log,
                                             const float* d_skip, const float* norm_g, int it, bool dry) {
    const int tid = otid(), wid = tid >> 6, lane = tid & 63, fr = lane & 15, fq = lane >> 4;
    const int g = it & 1, bc = it >> 1, c = bc & 63, b = bc >> 6;
    const size_t tok0 = (size_t)b * SEQ + c * 128;
    lds_t Cs = lds, Bm = lds + 34816, XS = lds + 69632, acs = lds + 139264, dlt = lds + 141312, acsT = lds + 143360, dltT = lds + 145408, ssq = lds + 147456;
    __syncthreads();
    ssd_dt(acs, dlt, dtraw, dt_bias, a_log, tok0, g);
    { const int t = tid >> 2, hh = tid & 3; *(LAS float*)(acsT + (hh * 128 + t) * 4) = *(const LAS float*)(acs + tid * 4); *(LAS float*)(dltT + (hh * 128 + t) * 4) = *(const LAS float*)(dlt + tid * 4); }
    conv_tile<16, false>(Cs, 136, proj, tok0, c * 128, 768 + g * 128, cw, cb, acs);
    conv_tile<16, false>(Bm, 136, proj, tok0, c * 128, 512 + g * 128, cw, cb, acs);
    conv_tile<32, false>(XS, 272, proj, tok0, c * 128, g * 256, cw, cb, acs);
    __syncthreads();
    const int l = 16 * wid + fr;
    bf16x8 cf[4];
#pragma unroll
    for (int ks = 0; ks < 4; ++ks) cf[ks] = frag_row(Cs, 136, 16 * wid, 32 * ks, fr, fq);
    f32x4 cbT[8];
    { bf16x8 kf[2][8];
#pragma unroll
      for (int u = 0; u < 8; ++u) kf[0][u] = frag_row(Bm, 136, 16 * (u >> 2), 32 * (u & 3), fr, fq);
#pragma unroll
      for (int np = 0; np < 4; ++np) {
          if (np + 1 < 4) {
#pragma unroll
              for (int u = 0; u < 8; ++u) kf[(np + 1) & 1][u] = frag_row(Bm, 136, 16 * (2 * np + 2 + (u >> 2)), 32 * (u & 3), fr, fq); }
          __builtin_amdgcn_sched_barrier(0);
          cbT[2 * np] = (f32x4){0.f, 0.f, 0.f, 0.f}; cbT[2 * np + 1] = (f32x4){0.f, 0.f, 0.f, 0.f};
#pragma unroll
          for (int ks = 0; ks < 4; ++ks) { cbT[2 * np] = MFMA16(kf[np & 1][ks], cf[ks], cbT[2 * np]); cbT[2 * np + 1] = MFMA16(kf[np & 1][4 + ks], cf[ks], cbT[2 * np + 1]); }
          __builtin_amdgcn_sched_barrier(0); } }
    u16* gp = PJ(proj, tok0 + l, C_Z + g * 256 + 4 * fq);
#pragma unroll 1
    for (int hh = 0; hh < 4; ++hh) {
        const int h = 4 * g + hh;
        const u16* pv = ssdS + ((size_t)bc * 8 + h) * 8192 + (size_t)fr * 128 + 8 * fq;
        const float al = *(const LAS float*)(acsT + (hh * 128 + l) * 4);
        bf16x8 pf[16];
#pragma unroll
        for (int u = 0; u < 16; ++u) pf[u] = __builtin_bit_cast(bf16x8, *(const u32x4*)(pv + (size_t)(u >> 2) * 2048 + 32 * (u & 3)));
        bf16x8 bp[4];
#pragma unroll
        for (int k2 = 0; k2 < 4; ++k2) { f32x4 pa[2];
#pragma unroll
            for (int u = 0; u < 2; ++u) { const int n = 2 * k2 + u, s0 = 16 * n + 4 * fq;
                const f32x4 as = *(const LAS f32x4*)(acsT + (hh * 128 + s0) * 4), ds = *(const LAS f32x4*)(dltT + (hh * 128 + s0) * 4);
#pragma unroll
                for (int r = 0; r < 4; ++r) pa[u][r] = (s0 + r <= l) ? cbT[n][r] * __expf(al - as[r]) * ds[r] : 0.f; }
            bp[k2] = pack8(pa[0], pa[1]); }
        f32x4 yd[4], yo[4];
#pragma unroll
        for (int m = 0; m < 4; ++m) { yd[m] = (f32x4){0.f, 0.f, 0.f, 0.f}; yo[m] = (f32x4){0.f, 0.f, 0.f, 0.f}; }
#pragma unroll
        for (int hf = 0; hf < 2; ++hf) { bf16x8 xf[8];
#pragma unroll
            for (int u = 0; u < 8; ++u) xf[u] = frag_vt_ld(XS, 272, hh * 64 + 16 * (2 * hf + (u >> 2)), u & 3, fr, fq);
            __builtin_amdgcn_sched_barrier(0);
#pragma unroll
            for (int k2 = 0; k2 < 4; ++k2) { yd[2 * hf] = MFMA16(xf[k2], bp[k2], yd[2 * hf]); yd[2 * hf + 1] = MFMA16(xf[4 + k2], bp[k2], yd[2 * hf + 1]);
                yo[2 * hf] = MFMA16(pf[8 * hf + k2], cf[k2], yo[2 * hf]); yo[2 * hf + 1] = MFMA16(pf[8 * hf + 4 + k2], cf[k2], yo[2 * hf + 1]); }
            __builtin_amdgcn_sched_barrier(0); }
        const float dsk = d_skip[h], ea = __expf(al);
        float part = 0.f;
#pragma unroll
        for (int m = 0; m < 4; ++m) { const u32x2 xw = *(const LAS u32x2*)(XS + (l * 272 + hh * 64 + 16 * m + 4 * fq) * 2);
            u16* gz = PJ(proj, tok0 + l, C_Z + g * 256 + hh * 64 + 16 * m + 4 * fq);
            const u32x2 zw = *(const u32x2*)(gz);
            const float v0 = (yd[m][0] + ea * yo[m][0] + dsk * bflo(xw[0])) * siluf(bflo(zw[0])), v1 = (yd[m][1] + ea * yo[m][1] + dsk * bfhi(xw[0])) * siluf(bfhi(zw[0]));
            const float v2 = (yd[m][2] + ea * yo[m][2] + dsk * bflo(xw[1])) * siluf(bflo(zw[1])), v3 = (yd[m][3] + ea * yo[m][3] + dsk * bfhi(xw[1])) * siluf(bfhi(zw[1]));
            u32x2 o; o[0] = pk2(v0, v1); o[1] = pk2(v2, v3);
            if (!dry) *(u32x2*)(gz) = o;
            part += v0 * v0 + v1 * v1 + v2 * v2 + v3 * v3; }
        part += __shfl_xor(part, 16); part += __shfl_xor(part, 32);
        if (fq == 0) *(LAS float*)(ssq + (l * 4 + hh) * 4) = part;
    }
    __syncthreads();
    { const int r = tid >> 2, q4 = tid & 3;
      const f32x4 p0 = *(const LAS f32x4*)(ssq + r * 16);
      const float ss = p0[0] + p0[1] + p0[2] + p0[3];
      const float rr = rsqrtf(ss * (1.f / 256.f) + EPS);
      const int gqc = C_Z + g * 256 + q4 * 64;
      const float* ng = norm_g + g * 256 + q4 * 64;
#pragma unroll
      for (int i = 0; i < 8; ++i) { u16* gq = PJ(proj, tok0 + r, gqc + i * 8); const u32x4 zv = *(const u32x4*)(gq); const f32x4 g0 = *(const f32x4*)(ng + i * 8), g1 = *(const f32x4*)(ng + i * 8 + 4); u32x4 o;
          o[0] = pk2(bflo(zv[0]) * rr * g0[0], bfhi(zv[0]) * rr * g0[1]); o[1] = pk2(bflo(zv[1]) * rr * g0[2], bfhi(zv[1]) * rr * g0[3]);
          o[2] = pk2(bflo(zv[2]) * rr * g1[0], bfhi(zv[2]) * rr * g1[1]); o[3] = pk2(bflo(zv[3]) * rr * g1[2], bfhi(zv[3]) * rr * g1[3]);
          if (!dry) *(u32x4*)(gq) = o; } }
}

#define XB_TMO      128
#define XB_XCNT(j)  (256  + 64 * (j))
#define XB_XSUB(j)  (1280 + 64 * (j))
#define XB_XGEN(j)  (2304 + 64 * (j))
#define XB_TOP      3328
#define XB_TOPGEN   3392
#define XCD_BAR_WORDS 3456
#define XB_SPIN_CAP (1u << 18)

__device__ __forceinline__ unsigned xb_ld(unsigned* p)              { return __hip_atomic_load(p, __ATOMIC_RELAXED, __HIP_MEMORY_SCOPE_AGENT); }
__device__ __forceinline__ unsigned xb_add(unsigned* p, unsigned v) { return __hip_atomic_fetch_add(p, v, __ATOMIC_RELAXED, __HIP_MEMORY_SCOPE_AGENT); }
__device__ __forceinline__ unsigned xb_xcc_id() { return (unsigned)__builtin_amdgcn_s_getreg((3 << 11) | 20) & 0xFu; }
#define XB_SPIN(cond, bar) do { unsigned _sp = 0; while (cond) { __builtin_amdgcn_s_sleep(1); \
    if ((++_sp & 255u) == 0u) { if (xb_ld(&(bar)[XB_TMO])) break; if (_sp > XB_SPIN_CAP) { atomicAdd(&(bar)[XB_TMO], 1u); break; } } } } while (0)

struct XcdBarrier {
    unsigned* bar; unsigned x;
    volatile LAS unsigned* st;
};

__device__ __forceinline__ XcdBarrier xcd_barrier_post(unsigned* bar, volatile LAS unsigned* st) {
    XcdBarrier b; b.bar = bar; b.x = xb_xcc_id(); b.st = st;
    if (threadIdx.x == 0) (void)xb_add(&bar[XB_XCNT(b.x)], 1u);
    return b;
}
__device__ __forceinline__ void xcd_barrier_complete(unsigned* bar, unsigned x, unsigned& nloc, unsigned& nx) {
    const unsigned G = gridDim.x * gridDim.y * gridDim.z;
    unsigned sum, cnt, mine, sp = 0u;
    for (;;) {
        sum = 0u; cnt = 0u; mine = 0u;
#pragma unroll
        for (unsigned j = 0; j < 16; ++j) { const unsigned c = xb_ld(&bar[XB_XCNT(j)]); sum += c; cnt += (c > 0u) ? 1u : 0u; mine = (j == x) ? c : mine; }
        if (sum == G) break;
        __builtin_amdgcn_s_sleep(1);
        if ((++sp & 255u) == 0u) { if (xb_ld(&bar[XB_TMO])) break; if (sp > XB_SPIN_CAP) { atomicAdd(&bar[XB_TMO], 1u); break; } }
    }
    nloc = mine > 0u ? mine : 1u; nx = cnt > 0u ? cnt : 1u;
}

__device__ __forceinline__ void xcd_barrier(const XcdBarrier& b) {
    asm volatile("s_waitcnt vmcnt(0)" ::: "memory");
    __syncthreads();
    if (threadIdx.x == 0) {
        unsigned* bar = b.bar;
        __builtin_amdgcn_s_waitcnt(0);
        unsigned nloc = b.st[0], nx = b.st[1];
        if (nloc == 0u) { xcd_barrier_complete(bar, b.x, nloc, nx); b.st[0] = nloc; b.st[1] = nx; }
        const unsigned old = xb_add(&bar[XB_XSUB(b.x)], 1u);
        const unsigned gen = old / nloc;
        if (old + 1u == (gen + 1u) * nloc) {
            __builtin_amdgcn_fence(__ATOMIC_RELEASE, "agent");
            asm volatile("s_waitcnt vmcnt(0)" ::: "memory");
            const unsigned og = xb_add(&bar[XB_TOP], 1u);
            const unsigned tg = og / nx;
            if (og + 1u == (tg + 1u) * nx) xb_add(&bar[XB_TOPGEN], 1u);
            else XB_SPIN(xb_ld(&bar[XB_TOPGEN]) == tg, bar);
            __builtin_amdgcn_fence(__ATOMIC_ACQUIRE, "agent");
            xb_add(&bar[XB_XGEN(b.x)], 1u);
            asm volatile("s_waitcnt vmcnt(0)" ::: "memory");
        } else {
            XB_SPIN(xb_ld(&bar[XB_XGEN(b.x)]) == gen, bar);
            __builtin_amdgcn_fence(__ATOMIC_ACQUIRE, "agent");
            asm volatile("s_waitcnt vmcnt(0)" ::: "memory");
        }
    }
    __syncthreads();
}


__global__ void __launch_bounds__(NTHR, 2) hybrid_fwd(Params p0) {
    extern __shared__ __attribute__((aligned(16))) unsigned char shm_raw[];
    lds_t lds = (lds_t)shm_raw;
    cg::grid_group grid = cg::this_grid();
    volatile LAS unsigned* xst = (volatile LAS unsigned*)(lds + LDS_BYTES - 16);
    if (threadIdx.x == 0) { xst[0] = 0u; xst[1] = 0u; }
    __syncthreads();
    const XcdBarrier xb = xcd_barrier_post((unsigned*)(p0.ws + WS_BAR), xst);
    for (int pi = p0.ph_lo; pi < p0.ph_hi; ++pi) {
        if (pi > p0.ph_lo) { if (p0.ph_lo < 0) grid.sync();
            xcd_barrier(xb); }
        __builtin_amdgcn_s_setprio(0);
        const int ph = p0.prog[pi] & 63; const bool dry = (p0.prog[pi] & 64) != 0; const int im = dry ? p0.dmask : 1023;
        Params p = p0;
        asm volatile("" : "+s"(p.ws), "+s"(p.out));
        u16* proj = (u16*)(p.ws + WS_PROJ);
        u16* retS = (u16*)(p.ws + WS_ST); u16* ssdS = retS + 16777216; u16* yh = retS;
        u16* WinT = (u16*)(p.ws + WS_WIN); u16* WoutT = (u16*)(p.ws + WS_WOUT); u16* memkv = (u16*)(p.ws + WS_MEMKV);
        const float* rc = (const float*)(p.ws + WS_ROPE); const float* rs = rc + SEQ * 64;
        float* dtraw = (float*)(p.ws + WS_DT); float* cdec = (float*)(p.ws + WS_CDEC);
        if (ph == 0) { if (PM & 1) phase_prep(lds, p); continue; }
        const int layer = (ph - 1) / 6, k = (ph - 1) % 6;
        if ((k == 1 || k == 3) && __builtin_amdgcn_readfirstlane(otid()) >= 256) __builtin_amdgcn_s_setprio(1);
        if (k == 0 || k == 4 || (k == 2 && layer == 0 && !dry)) {
            const int njobs = (k == 2) ? 3 : 1;
            for (int j = (k == 2) ? 1 : 0; j < njobs; ++j) {
                pg8::Gemm g; int c = blockIdx.x;
                g.astream = 0; g.ostream = 0;
                if (k == 0) { g.A = yh; g.lda = 1024; g.Bt = WinT; g.ldb = 1024; g.M = T_TOK; g.N = NP; g.K = 1024; g.O = proj; g.ldc = NP; g.ostream = 1; }
                else if (k == 2) { const int l = j - 1; g.A = (const u16*)p.out + (size_t)l * 1048576; g.lda = 1024; g.Bt = (const u16*)p.out + 2097152 + (size_t)l * 1048576; g.ldb = 1024;
                    g.M = 1024; g.N = 1024; g.K = 1024; g.O = memkv + (size_t)l * 1048576; g.ldc = 1024; c = (int)((blockIdx.x + gridDim.x - 16u * l) % gridDim.x); }
                else { g.A = proj + (size_t)(C_RG >> 5) * STRM; g.lda = 32; g.astream = 1; g.Bt = WoutT; g.ldb = 2048; g.M = T_TOK; g.N = 1024; g.K = 2048; g.O = yh; g.ldc = 1024; }
                pg8::StaticOrder S; S.init(g.M, g.N, (int)gridDim.x, c);
                if (PM & 2) pg8::gemm_phase(lds, g, S);
            }
        } else if (k == 1) {
            const float* cw = p.conv_w + (size_t)layer * 4096; const float* cbias = p.conv_b + (size_t)layer * 1024;
            for (int it = blockIdx.x; it < 2560; it += gridDim.x) {
                if (it < 1024) { if (im & 4) sb_item(lds, proj, (it & ~63) | ((it + 16 * ((it >> 8) & 3)) & 63), dry); }
                else if (it < 2048) { const int i2 = it - 1024; if (im & 16) ret_state_item(lds, proj, retS, rc, rs, (i2 & ~(63 << 2)) | ((((i2 >> 2) + 16 * ((i2 >> 8) & 3)) & 63) << 2)); }
                else { const int i2 = it - 2048; if (im & 32) ssd_state_item(lds, proj, ssdS, cdec, dtraw, cw, cbias, p.dt_bias + layer * 8, p.a_log + layer * 8, (i2 & ~(63 << 1)) | ((((i2 >> 1) + 16 * ((i2 >> 8) & 1)) & 63) << 1)); }
            }
        }
        if (k == 2) {
            if ((PM & 64) && !dry) scan_phase(retS, ssdS, cdec, dry);
        } else if (k == 3) {
            const float* cw = p.conv_w + (size_t)layer * 4096; const float* cbias = p.conv_b + (size_t)layer * 1024;
            for (int it = blockIdx.x; it < 1536; it += gridDim.x) {
                if (it < 1024) { if (im & 128) ret_out_item(lds, proj, retS, rc, rs, (it & ~(63 << 2)) | ((((it >> 2) + 16 * ((it >> 8) & 3)) & 63) << 2), dry); }
                else { if (im & 256) ssd_out_item(lds, proj, ssdS, dtraw, cw, cbias, p.dt_bias + layer * 8, p.a_log + layer * 8, p.d_skip + layer * 8, p.ssd_norm_g + layer * 512, ((it - 1024) & ~(63 << 1)) | (((((it - 1024) >> 1) + 16 * (((it - 1024) >> 8) & 1)) & 63) << 1), dry); }
            }
            if (im & 8) mem_group(lds, proj, memkv + (size_t)layer * 1048576, dry);
        } else if (k == 5) {
            const bool has_next = layer == 0;
            if (has_next) { convert_win(lds, p.w_in + (size_t)1024 * DIN, WinT); convert_wout(lds, p.w_out + (size_t)2048 * 1024, WoutT); }
            if (PM & 512) row_pass(lds, layer == 0 ? p.x : p.out, p.out, yh, true, p.post_g + layer * 1024, has_next, p.pre_g + 1024, p.w_in + (size_t)1024 * DIN, dtraw, dry);
        }
    }
}


#ifdef DBG_STOP
__global__ void dbg_dump(Params p) {
    const u16* proj = (const u16*)(p.ws + WS_PROJ); const u16* st = (const u16*)(p.ws + WS_ST);
    const u16* mk = (const u16*)(p.ws + WS_MEMKV); const float* dt = (const float*)(p.ws + WS_DT); const float* cd = (const float*)(p.ws + WS_CDEC);
    const float* rp = (const float*)(p.ws + WS_ROPE);
    for (size_t i = (size_t)blockIdx.x * blockDim.x + threadIdx.x; i < (size_t)T_TOK * DM; i += (size_t)gridDim.x * blockDim.x) {
        float a = 0.f;
#if DBG_WHAT & 1
        for (int j = 0; j < 6; ++j) a += bf2f(proj[i * 6 + j]);
        a += bf2f(proj[201326592ull + (i >> 1)]);
#endif
#if DBG_WHAT & 2
        a += bf2f(st[i]);
#endif
#if DBG_WHAT & 4
        a += bf2f(mk[i & 2097151]) + dt[i & 262143] + cd[i & 2047] + rp[i & 1048575];
#endif
        p.out[i] = a;
    }
}
#endif

#ifdef DBG_STOP
constexpr int N_PHASES = DBG_STOP;
#else
constexpr int N_PHASES = 13;
#endif

extern "C" void kernel_launch(void* const* d_in, const int* in_sizes, int n_in, void* d_out, int out_size, void* d_ws, size_t ws_size, hipStream_t stream) {
    static int grid = 0;
    if (grid == 0) {
        if (n_in != 14 || in_sizes[0] != T_TOK * DM || out_size != T_TOK * DM || ws_size < WS_END) {
            fprintf(stderr, "kernel_launch: unexpected shapes (n_in %d, in0 %d, out %d, ws %zu need %zu)\n", n_in, n_in > 0 ? in_sizes[0] : -1, out_size, ws_size, (size_t)WS_END); grid = -1; return; }
        int dev = 0, cus = 0, per_cu = 0;
        hipGetDevice(&dev); hipDeviceGetAttribute(&cus, hipDeviceAttributeMultiprocessorCount, dev);
        if (hipFuncSetAttribute((const void*)hybrid_fwd, hipFuncAttributeMaxDynamicSharedMemorySize, LDS_BYTES) != hipSuccess) { fprintf(stderr, "kernel_launch: hipFuncSetAttribute failed\n"); grid = -1; return; }
        if (hipOccupancyMaxActiveBlocksPerMultiprocessor(&per_cu, (const void*)hybrid_fwd, NTHR, LDS_BYTES) != hipSuccess || per_cu < 1) per_cu = 1;
        (void)hipGetLastError();
        grid = cus * 1;
    }
    if (grid < 0) return;
    if (hipMemsetAsync((char*)d_ws + WS_BAR, 0, 16384, stream) != hipSuccess) { fprintf(stderr, "kernel_launch: memset failed\n"); return; }
    Params p{};
    p.x = (const float*)d_in[0]; p.mem = (const float*)d_in[1]; p.pre_g = (const float*)d_in[2]; p.post_g = (const float*)d_in[3]; p.w_in = (const float*)d_in[4];
    p.conv_w = (const float*)d_in[5]; p.conv_b = (const float*)d_in[6]; p.dt_bias = (const float*)d_in[7]; p.a_log = (const float*)d_in[8]; p.d_skip = (const float*)d_in[9];
    p.ssd_norm_g = (const float*)d_in[10]; p.mem_norm_g = (const float*)d_in[11]; p.w_mem_kv = (const float*)d_in[12]; p.w_out = (const float*)d_in[13];
    p.out = (float*)d_out; p.ws = (unsigned char*)d_ws;
    int np = 0;
#ifdef DMASK
    p.dmask = DMASK;
#else
    p.dmask = 1023;
#endif
    for (int ph = 0; ph < N_PHASES; ++ph) { p.prog[np++] = (unsigned char)ph;
#ifdef DUP_PHASE
        if (ph == DUP_PHASE) for (int d = 0; d < DUP_TIMES; ++d) p.prog[np++] = (unsigned char)(ph | 64);
#endif
    }
#if N_LAUNCH_MODE == 1
    p.ph_lo = 0; p.ph_hi = np;
    void* args[] = {&p};
    hipError_t e = hipLaunchCooperativeKernel((const void*)hybrid_fwd, dim3(grid), dim3(NTHR), args, LDS_BYTES, stream);
    if (e != hipSuccess) fprintf(stderr, "cooperative launch failed: %s (grid %d)\n", hipGetErrorString(e), grid);
#else
    for (int ph = 0; ph < np; ++ph) { p.ph_lo = ph; p.ph_hi = ph + 1; hipLaunchKernelGGL(hybrid_fwd, dim3(grid), dim3(NTHR), LDS_BYTES, stream, p); }
#ifdef DBG_STOP
    p.ph_lo = 0; p.ph_hi = 0; hipLaunchKernelGGL(dbg_dump, dim3(2048), dim3(256), 0, stream, p);
#endif
#endif
}
```

```cpp
#include <hip/hip_runtime.h>
#include <hip/hip_cooperative_groups.h>
#include <cstdio>
namespace cg = cooperative_groups;

#define LAS __attribute__((address_space(3)))
typedef unsigned short u16;
typedef short bf16x8 __attribute__((ext_vector_type(8)));
typedef short s16x4 __attribute__((ext_vector_type(4)));
typedef float f32x4 __attribute__((ext_vector_type(4)));
typedef unsigned u32x4 __attribute__((ext_vector_type(4)));
typedef unsigned u32x2 __attribute__((ext_vector_type(2)));
typedef LAS unsigned char* lds_t;

#ifndef N_LAUNCH_MODE
#define N_LAUNCH_MODE 1
#endif

constexpr int T_TOK = 32768, SEQ = 8192, DM = 1024, NP = 6656, DIN = 6664, NCHUNK = 64;
constexpr int C_RQ = 0, C_RK = 512, C_RV = 1024, C_XBC = 1536, C_SQ = 2560, C_SK = 3072, C_SV = 3584, C_MQ = 4096,
              C_RG = 4608, C_Z = 5120, C_SG = 5632, C_MG = 6144;
constexpr float EPS = 1e-6f;
constexpr int NTHR = 512;
#ifndef PM
#define PM 1023
#endif
constexpr int LDS_BYTES = 151552;

constexpr size_t WS_PROJ = 0;
constexpr size_t WS_ST = 436207616ull;
constexpr size_t WS_WIN = WS_ST + 67108864ull;
constexpr size_t WS_WOUT = WS_WIN + 13631488ull;
constexpr size_t WS_MEMKV = WS_WOUT + 4194304ull;
constexpr size_t WS_ROPE = WS_MEMKV + 4194304ull;
constexpr size_t WS_DT = WS_ROPE + 4194304ull;
constexpr size_t WS_CDEC = WS_DT + 1048576ull;
constexpr size_t WS_BAR = WS_CDEC + 8192ull;
constexpr size_t WS_END = WS_BAR + 16384ull;

constexpr size_t STRM = (size_t)T_TOK * 32;
__device__ __forceinline__ unsigned short* PJ(unsigned short* proj, size_t tok, int col) { return proj + (size_t)(col >> 5) * STRM + tok * 32 + (col & 31); }
__device__ __forceinline__ const unsigned short* PJ(const unsigned short* proj, size_t tok, int col) { return proj + (size_t)(col >> 5) * STRM + tok * 32 + (col & 31); }

struct Params {
    const float* x; const float* mem; const float* pre_g; const float* post_g; const float* w_in; const float* conv_w; const float* conv_b;
    const float* dt_bias; const float* a_log; const float* d_skip; const float* ssd_norm_g; const float* mem_norm_g; const float* w_mem_kv; const float* w_out;
    float* out; unsigned char* ws; int ph_lo, ph_hi; unsigned char prog[32]; int dmask, pad_;
};

typedef __bf16 bf16x2_t __attribute__((ext_vector_type(2)));
typedef float f32x2_t __attribute__((ext_vector_type(2)));
__device__ __forceinline__ unsigned pk2(float lo, float hi) { const f32x2_t v = {lo, hi}; const bf16x2_t b = __builtin_convertvector(v, bf16x2_t); return __builtin_bit_cast(unsigned, b); }
__device__ __forceinline__ u16 f2bf(float f) { return (u16)(pk2(f, 0.f) & 0xffffu); }
__device__ __forceinline__ float bf2f(u16 b) { return __uint_as_float(((unsigned)b) << 16); }
__device__ __forceinline__ float bflo(unsigned w) { return __uint_as_float(w << 16); }
__device__ __forceinline__ float bfhi(unsigned w) { return __uint_as_float(w & 0xffff0000u); }
__device__ __forceinline__ float siluf(float v) { return v / (1.f + __expf(-v)); }
__device__ __forceinline__ float softplusf(float x) { return fmaxf(x, 0.f) + log1pf(__expf(-fabsf(x))); }
__device__ __forceinline__ int otid() { int t = __builtin_amdgcn_workitem_id_x(); asm volatile("" : "+v"(t)); return t; }
#define MFMA16(a, b, c) __builtin_amdgcn_mfma_f32_16x16x32_bf16(a, b, c, 0, 0, 0)

__device__ __forceinline__ bf16x8 frag_row(lds_t base, int ld, int i0, int k0, int fr, int fq) {
    return *(const LAS bf16x8*)(base + ((i0 + fr) * ld + k0 + fq * 8) * 2);
}
__device__ __forceinline__ s16x4 trrd(lds_t p) { return __builtin_bit_cast(s16x4, __builtin_amdgcn_ds_read_tr16_b64_v4i16((LAS s16x4*)p)); }
__device__ __forceinline__ bf16x8 frag_tr(lds_t base, int ld, int i0, int k0, int fr, int fq) {
    lds_t p = base + ((k0 + 8 * fq + (fr >> 2)) * ld + i0 + 4 * (fr & 3)) * 2;
    const s16x4 lo = trrd(p), hi = trrd(p + 8 * ld);
    return (bf16x8){lo[0], lo[1], lo[2], lo[3], hi[0], hi[1], hi[2], hi[3]};
}
__device__ __forceinline__ void copy_tile(lds_t dst, int ldd, const u16* src, size_t lds_, int rows, int cpr_shift) {
    const int n = rows << cpr_shift;
#pragma unroll
    for (int i = otid(); i < n; i += NTHR) { const int r = i >> cpr_shift, ch = i & ((1 << cpr_shift) - 1);
        const u32x4 v = *(const u32x4*)(src + (size_t)r * lds_ + ch * 8);
        *(LAS u32x4*)(dst + (r * ldd + ch * 8) * 2) = v; }
}
__device__ __forceinline__ void copy_tile_pj(lds_t dst, int ldd, const unsigned short* proj, size_t tok0, int col) {
#pragma unroll
    for (int i = otid(); i < 2048; i += NTHR) { const int r = (i >> 2) & 127, ch = ((i >> 9) << 2) | (i & 3);
        const u32x4 v = *(const u32x4*)PJ(proj, tok0 + r, col + ch * 8);
        *(LAS u32x4*)(dst + (r * ldd + ch * 8) * 2) = v; }
}
__device__ __forceinline__ void rope_tile(lds_t dst, const u16* proj, size_t tok0, int col, const float* rc, const float* rs, int pos0, float bscale, float zl2) {
#pragma unroll
    for (int i = otid(); i < 1024; i += NTHR) { const int m = (i >> 2) & 127, ch = ((i >> 9) << 2) | (i & 3);
        const u32x4 a = *(const u32x4*)PJ(proj, tok0 + m, col + ch * 8), b = *(const u32x4*)PJ(proj, tok0 + m, col + 64 + ch * 8);
        const float* cp = rc + (size_t)(pos0 + m) * 64 + ch * 8; const float* sp = rs + (size_t)(pos0 + m) * 64 + ch * 8;
        const f32x4 c0 = *(const f32x4*)cp, c1 = *(const f32x4*)(cp + 4), s0 = *(const f32x4*)sp, s1 = *(const f32x4*)(sp + 4);
        const float sc = bscale * exp2f(zl2 * (float)(127 - m));
        float t1[8], t2[8], cc[8], ss[8], o1[8], o2[8];
#pragma unroll
        for (int e = 0; e < 4; ++e) { t1[2 * e] = bflo(a[e]); t1[2 * e + 1] = bfhi(a[e]); t2[2 * e] = bflo(b[e]); t2[2 * e + 1] = bfhi(b[e]);
            cc[e] = c0[e]; cc[e + 4] = c1[e]; ss[e] = s0[e]; ss[e + 4] = s1[e]; }
#pragma unroll
        for (int e = 0; e < 8; ++e) { o1[e] = (t1[e] * cc[e] - t2[e] * ss[e]) * sc; o2[e] = (t2[e] * cc[e] + t1[e] * ss[e]) * sc; }
        u32x4 w1, w2;
#pragma unroll
        for (int e = 0; e < 4; ++e) { w1[e] = pk2(o1[2 * e], o1[2 * e + 1]); w2[e] = pk2(o2[2 * e], o2[2 * e + 1]); }
        *(LAS u32x4*)(dst + (m * 136 + ch * 8) * 2) = w1; *(LAS u32x4*)(dst + (m * 136 + 64 + ch * 8) * 2) = w2; }
}
template <int NCH, bool SCALE>
__device__ __forceinline__ void conv_tile(lds_t dst, int ldd, const u16* proj, size_t tok0, int pos0, int ch0, const float* cw, const float* cb, lds_t scl) {
    constexpr int TPC = NTHR / NCH, RPT = 128 / TPC;
    const int t = otid(), chunk = t % NCH, rs0 = (t / NCH) * RPT, ch = ch0 + chunk * 8;
    float w[4][8], bias[8];
#pragma unroll
    for (int j = 0; j < 4; ++j) { const f32x4 a = *(const f32x4*)(cw + j * 1024 + ch), b = *(const f32x4*)(cw + j * 1024 + ch + 4);
#pragma unroll
        for (int e = 0; e < 4; ++e) { w[j][e] = a[e]; w[j][e + 4] = b[e]; } }
    { const f32x4 a = *(const f32x4*)(cb + ch), b = *(const f32x4*)(cb + ch + 4);
#pragma unroll
      for (int e = 0; e < 4; ++e) { bias[e] = a[e]; bias[e + 4] = b[e]; } }
    u32x4 x[RPT + 3];
#pragma unroll
    for (int i = 0; i < RPT + 3; ++i) { const int rr = rs0 - 3 + i; x[i] = (u32x4){0u, 0u, 0u, 0u};
        if (pos0 + rr >= 0) x[i] = *(const u32x4*)PJ(proj, tok0 + rr, C_XBC + ch); }
#pragma unroll
    for (int i = 0; i < RPT; ++i) { const int r = rs0 + i;
        float acc[8];
#pragma unroll
        for (int e = 0; e < 8; ++e) acc[e] = bias[e];
#pragma unroll
        for (int j = 0; j < 4; ++j) { const u32x4 v = x[i + j];
#pragma unroll
            for (int e = 0; e < 4; ++e) { acc[2 * e] += w[j][2 * e] * bflo(v[e]); acc[2 * e + 1] += w[j][2 * e + 1] * bfhi(v[e]); } }
        float sc = 1.f;
        if (SCALE) sc = *(const LAS float*)(scl + (r * 4 + (chunk >> 3)) * 4);
        u32x4 o;
#pragma unroll
        for (int e = 0; e < 4; ++e) o[e] = pk2(siluf(acc[2 * e]) * sc, siluf(acc[2 * e + 1]) * sc);
        *(LAS u32x4*)(dst + (r * ldd + chunk * 8) * 2) = o;
    }
}

namespace pg8 {
constexpr int BM = 256, BK = 64, HALF = 128, HTB = HALF * BK * 2, STAGE_BYTES = 8 * HTB, NXCD = 8, WGM = 8;
__device__ __forceinline__ int lds_byte(int r, int c) { const int st = (r >> 4) * 2 + (c >> 5), rr = r & 15, cc = c & 31, ob = rr * 64 + cc * 2; return st * 1024 + (ob ^ (((ob >> 9) & 1) << 5)); }
__device__ __forceinline__ void stage_rc(int b, int& R, int& C) { const int st = b / 1024, sb = b % 1024, swz = sb ^ (((sb >> 9) & 1) << 5); R = (st >> 1) * 16 + swz / 64; C = (st & 1) * 32 + (swz % 64) / 2; }
__device__ __forceinline__ int perm32(int rho) { const int n = rho >> 4, i = rho & 15; return 8 * (i >> 2) + 4 * n + (i & 3); }
struct Unit { int pm, pn; };
struct Gemm { const u16* A; const u16* Bt; int M, N, K, lda, ldb; u16* O; int ldc; int astream, ostream; };
struct StaticOrder {
    int nM, nN, nwg, G, c;
    __device__ void init(int M, int N, int G_, int c_) { nM = M / BM; nN = N / BM; nwg = nM * nN; G = G_; c = c_; }
    __device__ bool next(int i, Unit& u) const {
        const long L = (long)i * G + c; if (L >= nwg) return false;
        int wgid = (int)L; { const int q = nwg / NXCD, r = nwg % NXCD, xcd = wgid % NXCD, off = wgid / NXCD; wgid = (xcd < r ? xcd * (q + 1) : r * (q + 1) + (xcd - r) * q) + off; }
        const int nig = WGM * nN, gid = wgid / nig, fm = gid * WGM, gsz = (nM - fm) < WGM ? (nM - fm) : WGM;
        u.pm = fm + ((wgid % nig) % gsz); u.pn = (wgid % nig) / gsz; return true;
    }
};
__device__ __forceinline__ void epi_bf16(const Gemm& g, const f32x4 (&acc)[2][2][4][2], const Unit& u, int wr, int wc, int fr, int fq) {
    const int row0 = u.pm * BM + wr * 64 + fr, col0 = u.pn * BM + wc * 32 + 8 * fq;
#pragma unroll
    for (int ai = 0; ai < 2; ++ai)
#pragma unroll
        for (int m = 0; m < 4; ++m) { const size_t row = (size_t)(row0 + ai * HALF + m * 16);
            u16* rowp = g.ostream ? g.O + (size_t)(8 * u.pn + wc) * STRM + row * 32 + 8 * fq : g.O + row * g.ldc + col0;
            const size_t bstep = g.ostream ? 4 * STRM : (size_t)HALF;
#pragma unroll
            for (int bj = 0; bj < 2; ++bj) { const f32x4 v0 = acc[ai][bj][m][0], v1 = acc[ai][bj][m][1];
                u32x4 w; w.x = pk2(v0[0], v0[1]); w.y = pk2(v0[2], v0[3]); w.z = pk2(v1[0], v1[1]); w.w = pk2(v1[2], v1[3]);
                *(u32x4*)(rowp + bj * bstep) = w; } }
}
__device__ __forceinline__ void gemm_phase(lds_t lds, const Gemm g, const StaticOrder& S) {
    const int tid = otid(), wid = __builtin_amdgcn_readfirstlane(tid >> 6), lane = tid & 63, wr = wid >> 2, wc = wid & 3, fr = lane & 15, fq = lane >> 4;
    const int K = g.K, nt = K / BK;
    unsigned voffA[2], voffB[2];
#pragma unroll
    for (int i = 0; i < 2; ++i) { int R, C; stage_rc(tid * 16 + i * 8192, R, C); const int Rb = (R & ~31) + perm32(R & 31);
        voffA[i] = g.astream ? (unsigned)((size_t)(C >> 5) * STRM + R * 32 + (C & 31)) * 2u : (unsigned)(R * g.lda + C) * 2u; voffB[i] = (unsigned)(Rb * g.ldb + C) * 2u; }
    const size_t kstep = (size_t)(BK * 2);
    const bool astr = g.astream != 0;
#define PG8_KOFFA(t) (astr ? (size_t)(t) * (STRM * 4) : (size_t)(t) * 128)
    const size_t hstepA = (size_t)HALF * g.lda * 2, hstepB = (size_t)HALF * g.ldb * 2;
    const size_t tstepA = 2 * hstepA, tstepB = 2 * hstepB;
    const unsigned ldsw = (unsigned)wid * 1024u;
    const int aoff = lds_byte(wr * 64 + fr, fq * 8), boff = lds_byte(wc * 32 + fr, fq * 8);
#define PG8_SA(b, h) (((b) * 2 + (h)) * HTB)
#define PG8_SB(b, h) ((4 + (b) * 2 + (h)) * HTB)
#define PG8_STAGE(bufoff, gbase, voff) do { _Pragma("unroll") for (int _i = 0; _i < 2; ++_i) \
        __builtin_amdgcn_global_load_lds((const unsigned*)((const char*)(gbase) + (voff)[_i]), (LAS unsigned*)(lds + (bufoff) + ldsw + _i * 8192), 16, 0, 0); } while (0)
#define PG8_LDA(dst, b, h) do { _Pragma("unroll") for (int m = 0; m < 4; ++m) _Pragma("unroll") for (int k = 0; k < 2; ++k) dst[m][k] = *(const LAS bf16x8*)(lds + PG8_SA(b, h) + aoff + m * 2048 + k * 1024); } while (0)
#define PG8_LDB(dst, b, h) do { _Pragma("unroll") for (int n = 0; n < 2; ++n) _Pragma("unroll") for (int k = 0; k < 2; ++k) dst[n][k] = *(const LAS bf16x8*)(lds + PG8_SB(b, h) + boff + n * 2048 + k * 1024); } while (0)
#define PG8_MMA(ai, bj, At, Bt) do { __builtin_amdgcn_s_setprio(1); _Pragma("unroll") for (int m = 0; m < 4; ++m) _Pragma("unroll") for (int n = 0; n < 2; ++n) _Pragma("unroll") for (int k = 0; k < 2; ++k) \
        acc[ai][bj][m][n] = __builtin_amdgcn_mfma_f32_16x16x32_bf16(Bt[n][k], At[m][k], acc[ai][bj][m][n], 0, 0, 0); __builtin_amdgcn_s_setprio(0); } while (0)
#define PG8_WAIT_V(n) asm volatile("s_waitcnt vmcnt(" #n ")" ::: "memory")
#define PG8_WAIT_L(n) asm volatile("s_waitcnt lgkmcnt(" #n ")" ::: "memory")
#define PG8_BAR __builtin_amdgcn_s_barrier()
#define PG8_SCHED __builtin_amdgcn_sched_barrier(0)
    Unit cur, nxt; int ui = 0;
    if (!S.next(0, cur)) return;
    f32x4 acc[2][2][4][2];
#pragma unroll
    for (int a = 0; a < 2; ++a)
#pragma unroll
        for (int b = 0; b < 2; ++b)
#pragma unroll
            for (int m = 0; m < 4; ++m)
#pragma unroll
                for (int n = 0; n < 2; ++n) acc[a][b][m][n] = (f32x4){0.f, 0.f, 0.f, 0.f};
    bf16x8 At[4][2], B0[2][2], B1[2][2];
    const char* cA = (const char*)g.A + (size_t)cur.pm * tstepA; const char* cB = (const char*)g.Bt + (size_t)cur.pn * tstepB;
    PG8_STAGE(PG8_SB(0, 0), cB, voffB); PG8_STAGE(PG8_SA(0, 0), cA, voffA); PG8_STAGE(PG8_SB(0, 1), cB + hstepB, voffB); PG8_STAGE(PG8_SA(0, 1), cA + hstepA, voffA);
    if (wr == 1) PG8_BAR;
    PG8_WAIT_V(4); PG8_BAR;
    PG8_STAGE(PG8_SB(1, 0), cB + kstep, voffB); PG8_STAGE(PG8_SA(1, 0), cA + PG8_KOFFA(1), voffA); PG8_STAGE(PG8_SB(1, 1), cB + hstepB + kstep, voffB);
    PG8_WAIT_V(6); PG8_BAR;
    for (;;) {
        const bool has_next = S.next(ui + 1, nxt);
        const char* nA = has_next ? (const char*)g.A + (size_t)nxt.pm * tstepA : cA; const char* nB = has_next ? (const char*)g.Bt + (size_t)nxt.pn * tstepB : cB;
        for (int t = 0; t < nt; t += 2) {
            const bool last = (t == nt - 2);
            const char* a1 = cA + PG8_KOFFA(t + 1);
            const char* a2 = last ? nA : cA + PG8_KOFFA(t + 2); const char* b2 = last ? nB : cB + (size_t)(t + 2) * kstep;
            const char* a3 = last ? nA + PG8_KOFFA(1) : cA + PG8_KOFFA(t + 3); const char* b3 = b2 + kstep;
            PG8_LDB(B0, 0, 0); PG8_SCHED; PG8_LDA(At, 0, 0); PG8_STAGE(PG8_SA(1, 1), a1 + hstepA, voffA);
            PG8_WAIT_L(8); PG8_BAR; PG8_WAIT_L(0); PG8_MMA(0, 0, At, B0); PG8_BAR; PG8_SCHED;
            PG8_LDB(B1, 0, 1); PG8_STAGE(PG8_SB(0, 0), b2, voffB);
            PG8_BAR; PG8_WAIT_L(0); PG8_MMA(0, 1, At, B1); PG8_BAR;
            PG8_LDA(At, 0, 1); PG8_STAGE(PG8_SA(0, 0), a2, voffA);
            PG8_BAR; PG8_WAIT_L(0); PG8_MMA(1, 0, At, B0); PG8_BAR; PG8_SCHED;
            PG8_STAGE(PG8_SB(0, 1), b2 + hstepB, voffB);
            PG8_WAIT_V(6); PG8_BAR; PG8_MMA(1, 1, At, B1); PG8_BAR;
            PG8_LDB(B0, 1, 0); PG8_SCHED; PG8_LDA(At, 1, 0); PG8_STAGE(PG8_SA(0, 1), a2 + hstepA, voffA);
            PG8_WAIT_L(8); PG8_BAR; PG8_WAIT_L(0); PG8_MMA(0, 0, At, B0); PG8_BAR; PG8_SCHED;
            PG8_LDB(B1, 1, 1); PG8_STAGE(PG8_SB(1, 0), b3, voffB);
            PG8_BAR; PG8_WAIT_L(0); PG8_MMA(0, 1, At, B1); PG8_BAR;
            PG8_LDA(At, 1, 1); PG8_STAGE(PG8_SA(1, 0), a3, voffA);
            PG8_BAR; PG8_WAIT_L(0); PG8_MMA(1, 0, At, B0); PG8_BAR; PG8_SCHED;
            PG8_STAGE(PG8_SB(1, 1), b3 + hstepB, voffB);
            PG8_WAIT_V(6); PG8_BAR; PG8_MMA(1, 1, At, B1); PG8_BAR;
        }
        epi_bf16(g, acc, cur, wr, wc, fr, fq);
        if (!has_next) break;
#pragma unroll
        for (int a = 0; a < 2; ++a)
#pragma unroll
            for (int b = 0; b < 2; ++b)
#pragma unroll
                for (int m = 0; m < 4; ++m)
#pragma unroll
                    for (int n = 0; n < 2; ++n) acc[a][b][m][n] = (f32x4){0.f, 0.f, 0.f, 0.f};
        cur = nxt; cA = nA; cB = nB; ++ui;
    }
    PG8_WAIT_V(0);
    if (wr == 0) PG8_BAR;
    PG8_BAR;
#undef PG8_KOFFA
#undef PG8_SA
#undef PG8_SB
#undef PG8_STAGE
#undef PG8_LDA
#undef PG8_LDB
#undef PG8_MMA
#undef PG8_WAIT_V
#undef PG8_WAIT_L
#undef PG8_BAR
#undef PG8_SCHED
}
}

__device__ __forceinline__ int win_srccol(int seg) {
    switch (seg) { case 0: return 0; case 1: return 512; case 2: return 1024; case 3: return 2048; case 4: return 2560; case 5: return 3592; case 6: return 4104;
                   case 7: return 4616; case 8: return 5640; case 9: return 1536; case 10: return 3072; case 11: return 5128; default: return 6152; }
}
__device__ __forceinline__ void wt_tile(lds_t lds, const float* src, int src_ld, int scol0, u16* dst, int K, int k0, int n0) {
    const int c = otid() & 63, r8 = otid() >> 6;
#pragma unroll
    for (int i = 0; i < 8; ++i) { const int r = r8 + 8 * i; *(LAS float*)(lds + (r * 65 + c) * 4) = src[(size_t)(k0 + r) * src_ld + scol0 + c]; }
    __syncthreads();
#pragma unroll
    for (int i = 0; i < 8; ++i) { const int nn = r8 + 8 * i; dst[(size_t)(n0 + nn) * K + k0 + c] = f2bf(*(const LAS float*)(lds + (c * 65 + nn) * 4)); }
    __syncthreads();
}
template <bool WIN>
__device__ __forceinline__ void convert_mat(lds_t lds, const float* src, int src_ld, u16* dst, int K, int kshift  , int nunits) {
    const int c = otid() & 63, r8 = otid() >> 6, G = gridDim.x;
    for (int u0 = blockIdx.x; u0 < nunits; u0 += 4 * G) {
        float v[4][8];
#pragma unroll
        for (int q = 0; q < 4; ++q) { const int u = u0 + q * G; const bool ok = u < nunits; const int uu = ok ? u : u0;
            const int kt = uu & ((1 << kshift) - 1), n0 = (uu >> kshift) * 64, k0 = kt * 64;
            const int sc = WIN ? (win_srccol(n0 >> 9) + (n0 & 511)) : n0;
#pragma unroll
            for (int i = 0; i < 8; ++i) v[q][i] = src[(size_t)(k0 + r8 + 8 * i) * src_ld + sc + c]; }
#pragma unroll
        for (int q = 0; q < 4; ++q)
#pragma unroll
            for (int i = 0; i < 8; ++i) *(LAS float*)(lds + q * 16640 + ((r8 + 8 * i) * 65 + c) * 4) = v[q][i];
        __syncthreads();
#pragma unroll
        for (int q = 0; q < 4; ++q) { const int u = u0 + q * G; if (u < nunits) { const int kt = u & ((1 << kshift) - 1), n0 = (u >> kshift) * 64, k0 = kt * 64;
#pragma unroll
            for (int i = 0; i < 8; ++i) { const int nn = r8 + 8 * i; dst[(size_t)(n0 + nn) * K + k0 + c] = f2bf(*(const LAS float*)(lds + q * 16640 + (c * 65 + nn) * 4)); } } }
        __syncthreads();
    }
}
__device__ __forceinline__ void convert_win(lds_t lds, const float* w_in_l, u16* WinT) { convert_mat<true>(lds, w_in_l, DIN, WinT, 1024, 4, 16 * 104); }
__device__ __forceinline__ void convert_wout(lds_t lds, const float* w_out_l, u16* WoutT) { convert_mat<false>(lds, w_out_l, 1024, WoutT, 2048, 5, 32 * 16); }
__device__ __forceinline__ float wave_sum(float v) {
#pragma unroll
    for (int m = 32; m >= 1; m >>= 1) v += __shfl_xor(v, m);
    return v;
}
__device__ __forceinline__ void row_pass(lds_t lds, const float* xin, float* xout, u16* yh, bool has_y, const float* post_g, bool has_next, const float* pre_g, const float* w_in_next, float* dtraw, bool dry) {
    const int tid = otid(), wid = tid >> 6, lane = tid & 63;
    if (has_next) { for (int i = tid; i < 8192; i += NTHR) { const int k = i >> 3, j = i & 7; *(LAS float*)(lds + (j * 1024 + k) * 4) = w_in_next[(size_t)k * DIN + 3584 + j]; } }
    __syncthreads();
    const int stride = gridDim.x * 8;
    int row = blockIdx.x * 8 + wid;
    f32x4 nx[4]; u32x2 ny[4];
#pragma unroll
    for (int i = 0; i < 4; ++i) { nx[i] = (f32x4){0.f, 0.f, 0.f, 0.f}; ny[i] = (u32x2){0u, 0u}; }
    if (row < T_TOK) {
#pragma unroll
        for (int i = 0; i < 4; ++i) { nx[i] = *(const f32x4*)(xin + (size_t)row * DM + i * 256 + lane * 4); if (has_y) ny[i] = *(const u32x2*)(yh + (size_t)row * DM + i * 256 + lane * 4); } }
    for (; row < T_TOK; row += stride) {
        f32x4 xv[4]; u32x2 yw[4];
#pragma unroll
        for (int i = 0; i < 4; ++i) { xv[i] = nx[i]; yw[i] = ny[i]; }
        const int nrow = row + stride;
        if (nrow < T_TOK) {
#pragma unroll
            for (int i = 0; i < 4; ++i) { nx[i] = *(const f32x4*)(xin + (size_t)nrow * DM + i * 256 + lane * 4); if (has_y) ny[i] = *(const u32x2*)(yh + (size_t)nrow * DM + i * 256 + lane * 4); } }
        if (has_y) {
            f32x4 yv[4]; float ss = 0.f;
#pragma unroll
            for (int i = 0; i < 4; ++i) { yv[i] = (f32x4){bflo(yw[i][0]), bfhi(yw[i][0]), bflo(yw[i][1]), bfhi(yw[i][1])}; ss += yv[i][0] * yv[i][0] + yv[i][1] * yv[i][1] + yv[i][2] * yv[i][2] + yv[i][3] * yv[i][3]; }
            ss = wave_sum(ss); const float r1 = rsqrtf(ss * (1.f / 1024.f) + EPS);
#pragma unroll
            for (int i = 0; i < 4; ++i) { const f32x4 g = *(const f32x4*)(post_g + i * 256 + lane * 4); xv[i] += yv[i] * r1 * g; if (!dry) *(f32x4*)(xout + (size_t)row * DM + i * 256 + lane * 4) = xv[i]; }
        }
        if (has_next) {
            float ss = 0.f;
#pragma unroll
            for (int i = 0; i < 4; ++i) ss += xv[i][0] * xv[i][0] + xv[i][1] * xv[i][1] + xv[i][2] * xv[i][2] + xv[i][3] * xv[i][3];
            ss = wave_sum(ss); const float r2 = rsqrtf(ss * (1.f / 1024.f) + EPS);
            float d[8];
#pragma unroll
            for (int j = 0; j < 8; ++j) d[j] = 0.f;
#pragma unroll
            for (int i = 0; i < 4; ++i) { const f32x4 g = *(const f32x4*)(pre_g + i * 256 + lane * 4); const f32x4 h = xv[i] * r2 * g;
                u32x2 w; w[0] = pk2(h[0], h[1]); w[1] = pk2(h[2], h[3]); if (!dry) *(u32x2*)(yh + (size_t)row * DM + i * 256 + lane * 4) = w;
#pragma unroll
                for (int j = 0; j < 8; ++j) { const f32x4 wv = *(const LAS f32x4*)(lds + (j * 1024 + i * 256 + lane * 4) * 4); d[j] += h[0] * wv[0] + h[1] * wv[1] + h[2] * wv[2] + h[3] * wv[3]; } }
            const bool b5 = (lane & 32) != 0, b4 = (lane & 16) != 0, b3 = (lane & 8) != 0;
            float e[4], f[2];
#pragma unroll
            for (int j = 0; j < 4; ++j) { const float snd = b5 ? d[j] : d[j + 4], kp = b5 ? d[j + 4] : d[j]; e[j] = kp + __shfl_xor(snd, 32); }
#pragma unroll
            for (int j = 0; j < 2; ++j) { const float snd = b4 ? e[j] : e[j + 2], kp = b4 ? e[j + 2] : e[j]; f[j] = kp + __shfl_xor(snd, 16); }
            float gsum; { const float snd = b3 ? f[0] : f[1], kp = b3 ? f[1] : f[0]; gsum = kp + __shfl_xor(snd, 8); }
            gsum += __shfl_xor(gsum, 4); gsum += __shfl_xor(gsum, 2); gsum += __shfl_xor(gsum, 1);
            if ((lane & 7) == 0 && !dry) dtraw[(size_t)row * 8 + (b5 ? 4 : 0) + (b4 ? 2 : 0) + (b3 ? 1 : 0)] = gsum;
        }
    }
    __syncthreads();
}

__device__ __forceinline__ void phase_prep(lds_t lds, const Params& p) {
    u16* WinT = (u16*)(p.ws + WS_WIN); u16* WoutT = (u16*)(p.ws + WS_WOUT);
    u16* memn = (u16*)p.out; u16* WkvT = (u16*)p.out + 2 * 1024 * 1024;
    float* rc = (float*)(p.ws + WS_ROPE); float* rs = rc + SEQ * 64;
    convert_win(lds, p.w_in, WinT);
    convert_wout(lds, p.w_out, WoutT);
    convert_mat<false>(lds, p.w_mem_kv, 1024, WkvT, 1024, 4, 256);
    convert_mat<false>(lds, p.w_mem_kv + (size_t)1024 * 1024, 1024, WkvT + (size_t)1024 * 1024, 1024, 4, 256);
    for (int i = blockIdx.x * NTHR + otid(); i < SEQ * 64; i += gridDim.x * NTHR) { const int pos = i >> 6, f = i & 63;
        const float inv = exp2f(-(float)f * 0.20762050593046015f);
        const float ang = (float)pos * inv;
        const float kq = rintf(ang * 0.15915494309189535f);
        float rf = fmaf(-kq, 6.2831854820251465f, ang); rf = fmaf(-kq, -1.7484555e-7f, rf);
        rc[i] = __cosf(rf); rs[i] = __sinf(rf); }
    { const int wid = otid() >> 6, lane = otid() & 63;
      for (int row = blockIdx.x * 8 + wid; row < 2048; row += gridDim.x * 8) { const int l = row >> 10, r = row & 1023;
          f32x4 xv[4]; float ss = 0.f;
#pragma unroll
          for (int i = 0; i < 4; ++i) { xv[i] = *(const f32x4*)(p.mem + (size_t)r * DM + i * 256 + lane * 4); ss += xv[i][0] * xv[i][0] + xv[i][1] * xv[i][1] + xv[i][2] * xv[i][2] + xv[i][3] * xv[i][3]; }
          ss = wave_sum(ss); const float r2 = rsqrtf(ss * (1.f / 1024.f) + EPS);
#pragma unroll
          for (int i = 0; i < 4; ++i) { const f32x4 g = *(const f32x4*)(p.mem_norm_g + l * 1024 + i * 256 + lane * 4); const f32x4 h = xv[i] * r2 * g;
              u32x2 w; w[0] = pk2(h[0], h[1]); w[1] = pk2(h[2], h[3]); *(u32x2*)(memn + (size_t)row * DM + i * 256 + lane * 4) = w; } } }
    row_pass(lds, p.x, nullptr, (u16*)(p.ws + WS_ST), false, nullptr, true, p.pre_g, p.w_in, (float*)(p.ws + WS_DT), false);
}

__device__ __forceinline__ float ret_log2g(int h) { return log2f(1.f - exp2f(-5.f - (float)h)); }

__device__ __forceinline__ bf16x8 pack8(const f32x4& a, const f32x4& b) {
    u32x4 w; w[0] = pk2(a[0], a[1]); w[1] = pk2(a[2], a[3]); w[2] = pk2(b[0], b[1]); w[3] = pk2(b[2], b[3]); return __builtin_bit_cast(bf16x8, w);
}
__device__ __forceinline__ bf16x8 frag_vtl(lds_t base, int ld, int e0, int k2, int fr, int fq) {
    lds_t p = base + ((32 * k2 + 4 * fq + (fr >> 2)) * ld + e0 + 4 * (fr & 3)) * 2;
    const s16x4 lo = trrd(p), hi = trrd(p + 16 * ld * 2);
    return (bf16x8){lo[0], lo[1], lo[2], lo[3], hi[0], hi[1], hi[2], hi[3]};
}
__device__ __forceinline__ bf16x8 frag_vt(lds_t base, int e0, int k2, int fr, int fq) {
    lds_t p = base + ((32 * k2 + 4 * fq + (fr >> 2)) * 136 + e0 + 4 * (fr & 3)) * 2;
    const s16x4 lo = trrd(p), hi = trrd(p + 16 * 136 * 2);
    return (bf16x8){lo[0], lo[1], lo[2], lo[3], hi[0], hi[1], hi[2], hi[3]};
}
__device__ __forceinline__ void sb_item(lds_t lds, u16* proj, int it, bool dry) {
    const int tid = otid(), wid = tid >> 6, lane = tid & 63, fr = lane & 15, fq = lane >> 4;
    const int qb = it & 63, h = (it >> 6) & 3, b = it >> 8;
    const size_t tok0 = (size_t)b * SEQ + qb * 128;
    lds_t Ks = lds, Vs = lds + 17408, red = lds + 35840;
    const int tpos = qb * 128 + 16 * wid + fr;
    bf16x8 qf[4];
    {
#pragma unroll
      for (int ks = 0; ks < 4; ++ks) qf[ks] = __builtin_bit_cast(bf16x8, *(const u32x4*)PJ(proj, tok0 + 16 * wid + fr, C_SQ + h * 128 + 8 * fq + 32 * ks)); }
    const int sr = (tid >> 2) & 31, sc = ((tid >> 7) << 2) | (tid & 3);
    u32x4 kr0, kr1, vr0, vr1;
    { const size_t t0 = (size_t)b * SEQ + (2 * qb + 1) * 64 + sr; const u16* kp = PJ(proj, t0, C_SK + h * 128 + sc * 8); const size_t vo = (size_t)((C_SV - C_SK) >> 5) * STRM;
      kr0 = *(const u32x4*)(kp); kr1 = *(const u32x4*)(kp + 32 * 32); vr0 = *(const u32x4*)(kp + vo); vr1 = *(const u32x4*)(kp + vo + 32 * 32); }
    __syncthreads();
    *(LAS u32x4*)(Ks + (sr * 136 + sc * 8) * 2) = kr0; *(LAS u32x4*)(Ks + ((sr + 32) * 136 + sc * 8) * 2) = kr1;
    *(LAS u32x4*)(Vs + (sr * 144 + sc * 8) * 2) = vr0; *(LAS u32x4*)(Vs + ((sr + 32) * 144 + sc * 8) * 2) = vr1;
    __syncthreads();
    f32x4 O[8], carry = (f32x4){0.f, 0.f, 0.f, 0.f};
#pragma unroll
    for (int n = 0; n < 8; ++n) O[n] = (f32x4){0.f, 0.f, 0.f, 0.f};
    const bf16x8 ones = (bf16x8){0x3F80, 0x3F80, 0x3F80, 0x3F80, 0x3F80, 0x3F80, 0x3F80, 0x3F80};
    bf16x8 U00, U10;
#pragma unroll
    for (int jj = 0; jj < 8; ++jj) { const int j = (jj < 4 ? 4 * fq + jj : 16 + 4 * fq + jj - 4); U00[jj] = (j > fr) ? (short)0x3F80 : (short)0; U10[jj] = (j > 16 + fr) ? (short)0x3F80 : (short)0; }
    float wmax = 0.f;
    for (int kb = 2 * qb + 1; kb >= 0; --kb) {
        if (kb > 0) { const size_t t0 = (size_t)b * SEQ + (kb - 1) * 64 + sr; const u16* kp = PJ(proj, t0, C_SK + h * 128 + sc * 8); const size_t vo = (size_t)((C_SV - C_SK) >> 5) * STRM;
            kr0 = *(const u32x4*)(kp); kr1 = *(const u32x4*)(kp + 32 * 32); vr0 = *(const u32x4*)(kp + vo); vr1 = *(const u32x4*)(kp + vo + 32 * 32); }
        const bool active = (kb * 64 < qb * 128 + 16 * wid + 15) && !(wmax < -110.f);
        if (active) {
        f32x4 S[4];
        { bf16x8 kf[16];
#pragma unroll
          for (int u = 0; u < 16; ++u) kf[u] = frag_row(Ks, 136, 16 * (u & 3), 32 * (u >> 2), fr, fq);
          __builtin_amdgcn_sched_barrier(0);
#pragma unroll
          for (int n = 0; n < 4; ++n) S[n] = (f32x4){0.f, 0.f, 0.f, 0.f};
#pragma unroll
          for (int ks = 0; ks < 4; ++ks)
#pragma unroll
              for (int n = 0; n < 4; ++n) S[n] = MFMA16(kf[4 * ks + n], qf[ks], S[n]);
          __builtin_amdgcn_sched_barrier(0); }
        bf16x8 vf[16];
#pragma unroll
        for (int u = 0; u < 16; ++u) vf[u] = frag_vtl(Vs, 144, 16 * (u & 7), u >> 3, fr, fq);
        __builtin_amdgcn_sched_barrier(0);
        f32x4 E[4], Lh[4], Ll[4];
#pragma unroll
        for (int n = 0; n < 4; ++n) { const int sbase = kb * 64 + 16 * n + 4 * fq;
#pragma unroll
            for (int r = 0; r < 4; ++r) { const float xx = S[n][r] * 0.08838834764831845f; const float lg = __logf(1.f + __expf(-fabsf(xx)));
                const float L = -fmaxf(xx, 0.f) - lg; E[n][r] = fminf(xx, 0.f) - lg;
                const float Lm = (sbase + r < tpos) ? L : 0.f; const float hi = bf2f(f2bf(Lm));
                Lh[n][r] = hi; Ll[n][r] = Lm - hi; } }
        const bf16x8 bh0 = pack8(Lh[0], Lh[1]), bh1 = pack8(Lh[2], Lh[3]), bl0 = pack8(Ll[0], Ll[1]), bl1 = pack8(Ll[2], Ll[3]);
        f32x4 tail[4];
#pragma unroll
        for (int n = 0; n < 4; ++n) tail[n] = carry;
        tail[0] = MFMA16(U00, bh0, tail[0]); tail[0] = MFMA16(U00, bl0, tail[0]); tail[0] = MFMA16(ones, bh1, tail[0]); tail[0] = MFMA16(ones, bl1, tail[0]);
        tail[1] = MFMA16(U10, bh0, tail[1]); tail[1] = MFMA16(U10, bl0, tail[1]); tail[1] = MFMA16(ones, bh1, tail[1]); tail[1] = MFMA16(ones, bl1, tail[1]);
        tail[2] = MFMA16(U00, bh1, tail[2]); tail[2] = MFMA16(U00, bl1, tail[2]);
        tail[3] = MFMA16(U10, bh1, tail[3]); tail[3] = MFMA16(U10, bl1, tail[3]);
        carry = MFMA16(ones, bh0, carry); carry = MFMA16(ones, bl0, carry); carry = MFMA16(ones, bh1, carry); carry = MFMA16(ones, bl1, carry);
        f32x4 W[4];
#pragma unroll
        for (int n = 0; n < 4; ++n) { const int sbase = kb * 64 + 16 * n + 4 * fq;
#pragma unroll
            for (int r = 0; r < 4; ++r) W[n][r] = (sbase + r < tpos) ? __expf(E[n][r] + tail[n][r]) : 0.f; }
        const bf16x8 bw0 = pack8(W[0], W[1]), bw1 = pack8(W[2], W[3]);
#pragma unroll
        for (int n = 0; n < 8; ++n) O[n] = MFMA16(vf[n], bw0, O[n]);
#pragma unroll
        for (int n = 0; n < 8; ++n) O[n] = MFMA16(vf[8 + n], bw1, O[n]);
        { float m = carry[0]; m = fmaxf(m, __shfl_xor(m, 1)); m = fmaxf(m, __shfl_xor(m, 2)); m = fmaxf(m, __shfl_xor(m, 4)); m = fmaxf(m, __shfl_xor(m, 8)); wmax = m; }
        }
        if (lane == 0) *(LAS float*)(red + wid * 4) = wmax;
        __syncthreads();
        float bm = *(const LAS float*)(red);
#pragma unroll
        for (int w = 1; w < 8; ++w) bm = fmaxf(bm, *(const LAS float*)(red + w * 4));
        if (bm < -110.f || kb == 0) break;
        *(LAS u32x4*)(Ks + (sr * 136 + sc * 8) * 2) = kr0; *(LAS u32x4*)(Ks + ((sr + 32) * 136 + sc * 8) * 2) = kr1;
        *(LAS u32x4*)(Vs + (sr * 144 + sc * 8) * 2) = vr0; *(LAS u32x4*)(Vs + ((sr + 32) * 144 + sc * 8) * 2) = vr1;
        __syncthreads();
    }
#pragma unroll
    for (int n = 0; n < 8; ++n) { u16* gp = PJ(proj, tok0 + 16 * wid + fr, C_SG + h * 128 + 4 * fq + 16 * n); const u32x2 gv = *(const u32x2*)(gp); u32x2 o;
        o[0] = pk2(O[n][0] * siluf(bflo(gv[0])), O[n][1] * siluf(bfhi(gv[0]))); o[1] = pk2(O[n][2] * siluf(bflo(gv[1])), O[n][3] * siluf(bfhi(gv[1])));
        if (!dry) *(u32x2*)(gp) = o; }
}

__device__ __forceinline__ void mem_group(lds_t lds, u16* proj, const u16* memkv, bool dry) {
    const int tid = otid(), wid = tid >> 6, lane = tid & 63, fr = lane & 15, fq = lane >> 4;
    lds_t Km = lds, Vm = lds + 69632;
    int cur_bh = -1;
    for (int idx = blockIdx.x * 4; idx < 1024; idx += gridDim.x * 4) {
        const int bh = idx >> 6, b = bh >> 2, h = bh & 3;
        if (bh != cur_bh) { __syncthreads();
            copy_tile(Km, 136, memkv + (size_t)b * 256 * 1024 + h * 128, 1024, 256, 4);
            copy_tile(Vm, 144, memkv + (size_t)b * 256 * 1024 + 512 + h * 128, 1024, 256, 4);
            __syncthreads(); cur_bh = bh; }
        u32x4 qn[4];
        {
#pragma unroll
          for (int ks = 0; ks < 4; ++ks) qn[ks] = *(const u32x4*)PJ(proj, (size_t)b * SEQ + (idx & 63) * 128 + 16 * wid + fr, C_MQ + h * 128 + 8 * fq + 32 * ks); }
#pragma unroll 1
        for (int j = 0; j < 4; ++j) { const int tile = (idx + j) & 63;
            const size_t tok = (size_t)b * SEQ + tile * 128 + 16 * wid + fr;
            bf16x8 qf[4];
#pragma unroll
            for (int ks = 0; ks < 4; ++ks) qf[ks] = __builtin_bit_cast(bf16x8, qn[ks]);
            if (j < 3) {
#pragma unroll
                for (int ks = 0; ks < 4; ++ks) qn[ks] = *(const u32x4*)PJ(proj, tok + 128, C_MQ + h * 128 + 8 * fq + 32 * ks); }
            u32x2 gv[8];
#pragma unroll
            for (int n = 0; n < 8; ++n) gv[n] = *(const u32x2*)PJ(proj, tok, C_MG + h * 128 + 4 * fq + 16 * n);
            f32x4 S[16];
            { bf16x8 kf[2][8];
#pragma unroll
              for (int u = 0; u < 8; ++u) kf[0][u] = frag_row(Km, 136, 16 * (u >> 2), 32 * (u & 3), fr, fq);
#pragma unroll
              for (int np = 0; np < 8; ++np) {
                  if (np + 1 < 8) {
#pragma unroll
                      for (int u = 0; u < 8; ++u) kf[(np + 1) & 1][u] = frag_row(Km, 136, 16 * (2 * np + 2 + (u >> 2)), 32 * (u & 3), fr, fq); }
                  __builtin_amdgcn_sched_barrier(0);
                  S[2 * np] = (f32x4){0.f, 0.f, 0.f, 0.f}; S[2 * np + 1] = (f32x4){0.f, 0.f, 0.f, 0.f};
#pragma unroll
                  for (int ks = 0; ks < 4; ++ks) { S[2 * np] = MFMA16(kf[np & 1][ks], qf[ks], S[2 * np]); S[2 * np + 1] = MFMA16(kf[np & 1][4 + ks], qf[ks], S[2 * np + 1]); }
                  __builtin_amdgcn_sched_barrier(0); } }
            float m = S[0][0];
#pragma unroll
            for (int n = 0; n < 16; ++n)
#pragma unroll
                for (int r = 0; r < 4; ++r) m = fmaxf(m, S[n][r]);
            m = fmaxf(m, __shfl_xor(m, 16)); m = fmaxf(m, __shfl_xor(m, 32));
            float s = 0.f;
#pragma unroll
            for (int n = 0; n < 16; ++n)
#pragma unroll
                for (int r = 0; r < 4; ++r) { const float e = __expf((S[n][r] - m) * 0.08838834764831845f); S[n][r] = e; s += e; }
            s += __shfl_xor(s, 16); s += __shfl_xor(s, 32);
            const float inv = 1.f / s;
            f32x4 O[8];
#pragma unroll
            for (int n = 0; n < 8; ++n) O[n] = (f32x4){0.f, 0.f, 0.f, 0.f};
            { bf16x8 af[2][8];
#pragma unroll
              for (int n = 0; n < 8; ++n) af[0][n] = frag_vtl(Vm, 144, 16 * n, 0, fr, fq);
#pragma unroll
              for (int k2 = 0; k2 < 8; ++k2) { const bf16x8 bp = pack8(S[2 * k2], S[2 * k2 + 1]);
                  if (k2 + 1 < 8) {
#pragma unroll
                      for (int n = 0; n < 8; ++n) af[(k2 + 1) & 1][n] = frag_vtl(Vm, 144, 16 * n, k2 + 1, fr, fq); }
                  __builtin_amdgcn_sched_barrier(0);
#pragma unroll
                  for (int n = 0; n < 8; ++n) O[n] = MFMA16(af[k2 & 1][n], bp, O[n]);
                  __builtin_amdgcn_sched_barrier(0); } }
#pragma unroll
            for (int n = 0; n < 8; ++n) { u16* gp = PJ(proj, tok, C_MG + h * 128 + 4 * fq + 16 * n); u32x2 o;
                o[0] = pk2(O[n][0] * inv * siluf(bflo(gv[n][0])), O[n][1] * inv * siluf(bfhi(gv[n][0]))); o[1] = pk2(O[n][2] * inv * siluf(bflo(gv[n][1])), O[n][3] * inv * siluf(bfhi(gv[n][1])));
                if (!dry) *(u32x2*)(gp) = o; }
        }
    }
    __syncthreads();
}

__device__ __forceinline__ void ret_state_item(lds_t lds, const u16* proj, u16* retS, const float* rc, const float* rs, int it) {
    const int tid = otid(), wid = tid >> 6, lane = tid & 63, fr = lane & 15, fq = lane >> 4, wr = wid >> 1, wc = wid & 1;
    const int h = it & 3, bc = it >> 2, c = bc & 63, b = bc >> 6;
    const size_t tok0 = (size_t)b * SEQ + c * 128;
    lds_t KZ = lds, Vs = lds + 34816;
    __syncthreads();
    rope_tile(KZ, proj, tok0, C_RK + h * 128, rc, rs, c * 128, 0.08838834764831845f, ret_log2g(h));
    copy_tile_pj(Vs, 136, proj, tok0, C_RV + h * 128);
    __syncthreads();
    f32x4 acc[2][4];
#pragma unroll
    for (int m = 0; m < 2; ++m)
#pragma unroll
        for (int n = 0; n < 4; ++n) acc[m][n] = (f32x4){0.f, 0.f, 0.f, 0.f};
#pragma unroll
    for (int ks = 0; ks < 4; ++ks) { bf16x8 a[2], bq[4];
#pragma unroll
        for (int m = 0; m < 2; ++m) a[m] = frag_tr(Vs, 136, 32 * wr + 16 * m, 32 * ks, fr, fq);
#pragma unroll
        for (int n = 0; n < 4; ++n) bq[n] = frag_tr(KZ, 136, 64 * wc + 16 * n, 32 * ks, fr, fq);
#pragma unroll
        for (int m = 0; m < 2; ++m)
#pragma unroll
            for (int n = 0; n < 4; ++n) acc[m][n] = MFMA16(a[m], bq[n], acc[m][n]); }
    u16* dst = retS + (size_t)it * 16384;
#pragma unroll
    for (int m = 0; m < 2; ++m)
#pragma unroll
        for (int n = 0; n < 4; ++n)
#pragma unroll
            for (int r = 0; r < 4; ++r) dst[(32 * wr + 16 * m + 4 * fq + r) * 128 + 64 * wc + 16 * n + fr] = f2bf(acc[m][n][r]);
}

__device__ __forceinline__ void ssd_dt(lds_t acs, lds_t dlt, const float* dtraw, const float* dt_bias, const float* a_log, size_t tok0, int g) {
    const int tid = otid();
    { const int t = tid >> 2, hh = tid & 3, h = 4 * g + hh;
      const float dr = dtraw[(tok0 + t) * 8 + h] + dt_bias[h];
      const float delta = dr > 20.f ? dr : log1pf(__expf(dr));
      *(LAS float*)(dlt + tid * 4) = delta; *(LAS float*)(acs + tid * 4) = -delta * __expf(a_log[h]); }
    __syncthreads();
    if (tid < 256) { const int hh = tid >> 6, ln = tid & 63;
        const float v0 = *(const LAS float*)(acs + ((2 * ln) * 4 + hh) * 4), v1 = *(const LAS float*)(acs + ((2 * ln + 1) * 4 + hh) * 4);
        float sc = v0 + v1;
#pragma unroll
        for (int d = 1; d < 64; d <<= 1) { const float o = __shfl_up(sc, d); if (ln >= d) sc += o; }
        *(LAS float*)(acs + ((2 * ln) * 4 + hh) * 4) = sc - v1; *(LAS float*)(acs + ((2 * ln + 1) * 4 + hh) * 4) = sc; }
    __syncthreads();
}

__device__ __forceinline__ void ssd_state_item(lds_t lds, const u16* proj, u16* ssdS, float* cdec, const float* dtraw, const float* cw, const float* cb, const float* dt_bias, const float* a_log, int it) {
    const int tid = otid(), wid = tid >> 6, lane = tid & 63, fr = lane & 15, fq = lane >> 4, wr = wid >> 1, wc = wid & 1;
    const int g = it & 1, bc = it >> 1, c = bc & 63, b = bc >> 6;
    const size_t tok0 = (size_t)b * SEQ + c * 128;
    lds_t Bm = lds, XW = lds + 34816, acs = lds + 102400, dlt = lds + 104448, scl = lds + 106496;
    __syncthreads();
    ssd_dt(acs, dlt, dtraw, dt_bias, a_log, tok0, g);
    { const int hh = tid & 3; const float al = *(const LAS float*)(acs + (127 * 4 + hh) * 4);
      *(LAS float*)(scl + tid * 4) = *(const LAS float*)(dlt + tid * 4) * __expf(al - *(const LAS float*)(acs + tid * 4));
      if (tid < 4) cdec[(size_t)bc * 8 + 4 * g + tid] = __expf(al); }
    __syncthreads();
    conv_tile<16, false>(Bm, 136, proj, tok0, c * 128, 512 + g * 128, cw, cb, scl);
    conv_tile<32, true>(XW, 264, proj, tok0, c * 128, g * 256, cw, cb, scl);
    __syncthreads();
    u16* dst = ssdS + ((size_t)bc * 8 + 4 * g + wr) * 8192;
#pragma unroll 1
    for (int nh = 0; nh < 2; ++nh) {
        f32x4 acc[4][2];
#pragma unroll
        for (int m = 0; m < 4; ++m)
#pragma unroll
            for (int n = 0; n < 2; ++n) acc[m][n] = (f32x4){0.f, 0.f, 0.f, 0.f};
#pragma unroll
        for (int ks = 0; ks < 4; ++ks) { bf16x8 a[4], bq[2];
#pragma unroll
            for (int m = 0; m < 4; ++m) a[m] = frag_tr(XW, 264, 64 * wr + 16 * m, 32 * ks, fr, fq);
#pragma unroll
            for (int n = 0; n < 2; ++n) bq[n] = frag_tr(Bm, 136, 64 * wc + 32 * nh + 16 * n, 32 * ks, fr, fq);
#pragma unroll
            for (int m = 0; m < 4; ++m)
#pragma unroll
                for (int n = 0; n < 2; ++n) acc[m][n] = MFMA16(a[m], bq[n], acc[m][n]); }
#pragma unroll
        for (int m = 0; m < 4; ++m)
#pragma unroll
            for (int n = 0; n < 2; ++n)
#pragma unroll
                for (int r = 0; r < 4; ++r) dst[(16 * m + 4 * fq + r) * 128 + 64 * wc + 32 * nh + 16 * n + fr] = f2bf(acc[m][n][r]);
    }
}

__device__ __forceinline__ void scan_phase(u16* retS, u16* ssdS, const float* cdec, bool dry) {
    const int tid = otid();
    if (tid >= 256) return;
    for (int q = blockIdx.x * 256 + tid; q < 65536; q += gridDim.x * 256) {
        float st[8];
#pragma unroll
        for (int e = 0; e < 8; ++e) st[e] = 0.f;
        u16* p; const float* dp = nullptr; float dec0 = 0.f;
        if (q < 32768) { const int bh = q >> 11, e8 = q & 2047, b = bh >> 2, h = bh & 3;
            dec0 = exp2f(128.f * ret_log2g(h));
            p = retS + ((size_t)(b * 64) * 4 + h) * 16384 + e8 * 8;
        } else { const int q2 = q - 32768, bh = q2 >> 10, e8 = q2 & 1023, b = bh >> 3, h = bh & 7;
            p = ssdS + ((size_t)(b * 64) * 8 + h) * 8192 + e8 * 8; dp = cdec + (size_t)(b * 64) * 8 + h; }
#pragma unroll 16
        for (int c = 0; c < 64; ++c) { u32x4* pp = (u32x4*)(p + (size_t)c * 65536); const u32x4 v = *pp; const float dec = dp ? dp[c * 8] : dec0;
            u32x4 o;
#pragma unroll
            for (int e = 0; e < 4; ++e) o[e] = pk2(st[2 * e], st[2 * e + 1]);
            *pp = o;
#pragma unroll
            for (int e = 0; e < 4; ++e) { st[2 * e] = dec * st[2 * e] + bflo(v[e]); st[2 * e + 1] = dec * st[2 * e + 1] + bfhi(v[e]); } }
    }
}

__device__ __forceinline__ void ret_out_item(lds_t lds, u16* proj, const u16* retS, const float* rc, const float* rs, int it, bool dry) {
    const int tid = otid(), wid = tid >> 6, lane = tid & 63, fr = lane & 15, fq = lane >> 4, wr = wid >> 1, wc = wid & 1;
    const int h = it & 3, bc = it >> 2, c = bc & 63, b = bc >> 6;
    const size_t tok0 = (size_t)b * SEQ + c * 128;
    const float l2g = ret_log2g(h);
    lds_t Qs = lds, Ks = lds + 34816, Vs = lds + 69632, Rs = lds + 104448, Ys = lds;
    __syncthreads();
    rope_tile(Qs, proj, tok0, C_RQ + h * 128, rc, rs, c * 128, 1.f, 0.f);
    rope_tile(Ks, proj, tok0, C_RK + h * 128, rc, rs, c * 128, 0.08838834764831845f, 0.f);
    copy_tile_pj(Vs, 136, proj, tok0, C_RV + h * 128);
    copy_tile(Rs, 136, retS + (size_t)it * 16384, 128, 128, 4);
    __syncthreads();
    f32x4 a1[2][4], a2[2][4];
#pragma unroll
    for (int m = 0; m < 2; ++m)
#pragma unroll
        for (int n = 0; n < 4; ++n) { a1[m][n] = (f32x4){0.f, 0.f, 0.f, 0.f}; a2[m][n] = (f32x4){0.f, 0.f, 0.f, 0.f}; }
    { bf16x8 fb[2][10];
#pragma unroll
      for (int u = 0; u < 10; ++u) fb[0][u] = (u < 2) ? frag_row(Qs, 136, 32 * wr + 16 * u, 0, fr, fq) : (u < 6) ? frag_row(Ks, 136, 64 * wc + 16 * (u - 2), 0, fr, fq) : frag_row(Rs, 136, 64 * wc + 16 * (u - 6), 0, fr, fq);
#pragma unroll
      for (int ks = 0; ks < 4; ++ks) {
          if (ks + 1 < 4) {
#pragma unroll
              for (int u = 0; u < 10; ++u) fb[(ks + 1) & 1][u] = (u < 2) ? frag_row(Qs, 136, 32 * wr + 16 * u, 32 * (ks + 1), fr, fq) : (u < 6) ? frag_row(Ks, 136, 64 * wc + 16 * (u - 2), 32 * (ks + 1), fr, fq) : frag_row(Rs, 136, 64 * wc + 16 * (u - 6), 32 * (ks + 1), fr, fq); }
          __builtin_amdgcn_sched_barrier(0);
#pragma unroll
          for (int n = 0; n < 4; ++n)
#pragma unroll
              for (int m = 0; m < 2; ++m) { a1[m][n] = MFMA16(fb[ks & 1][m], fb[ks & 1][2 + n], a1[m][n]); a2[m][n] = MFMA16(fb[ks & 1][m], fb[ks & 1][6 + n], a2[m][n]); }
          __builtin_amdgcn_sched_barrier(0); } }
    __syncthreads();
#pragma unroll
    for (int m = 0; m < 2; ++m)
#pragma unroll
        for (int n = 0; n < 4; ++n)
#pragma unroll
            for (int r = 0; r < 4; ++r) { const int l = 32 * wr + 16 * m + 4 * fq + r, mm = 64 * wc + 16 * n + fr;
                const float pv = (l >= mm) ? a1[m][n][r] * exp2f(l2g * (float)(l - mm)) : 0.f;
                *(LAS u16*)(Ks + (l * 136 + mm) * 2) = f2bf(pv); }
    __syncthreads();
#pragma unroll
    for (int m = 0; m < 2; ++m)
#pragma unroll
        for (int n = 0; n < 4; ++n) a1[m][n] = (f32x4){0.f, 0.f, 0.f, 0.f};
    { bf16x8 fb[2][6];
#pragma unroll
      for (int u = 0; u < 6; ++u) fb[0][u] = (u < 2) ? frag_row(Ks, 136, 32 * wr + 16 * u, 0, fr, fq) : frag_tr(Vs, 136, 64 * wc + 16 * (u - 2), 0, fr, fq);
#pragma unroll
      for (int ks = 0; ks < 4; ++ks) {
          if (ks + 1 < 4) {
#pragma unroll
              for (int u = 0; u < 6; ++u) fb[(ks + 1) & 1][u] = (u < 2) ? frag_row(Ks, 136, 32 * wr + 16 * u, 32 * (ks + 1), fr, fq) : frag_tr(Vs, 136, 64 * wc + 16 * (u - 2), 32 * (ks + 1), fr, fq); }
          __builtin_amdgcn_sched_barrier(0);
#pragma unroll
          for (int n = 0; n < 4; ++n)
#pragma unroll
              for (int m = 0; m < 2; ++m) a1[m][n] = MFMA16(fb[ks & 1][m], fb[ks & 1][2 + n], a1[m][n]);
          __builtin_amdgcn_sched_barrier(0); } }
    __syncthreads();
#pragma unroll
    for (int m = 0; m < 2; ++m)
#pragma unroll
        for (int r = 0; r < 4; ++r) { const int l = 32 * wr + 16 * m + 4 * fq + r; const float xi = exp2f(l2g * (float)(l + 1));
#pragma unroll
            for (int n = 0; n < 4; ++n) *(LAS float*)(Ys + (l * 132 + 64 * wc + 16 * n + fr) * 4) = a1[m][n][r] + xi * a2[m][n][r]; }
    __syncthreads();
    { const int r = tid >> 2, q4 = tid & 3; float v[32]; float s = 0.f;
#pragma unroll
      for (int i = 0; i < 8; ++i) { const f32x4 t = *(const LAS f32x4*)(Ys + (r * 132 + q4 * 32 + i * 4) * 4); v[4 * i] = t[0]; v[4 * i + 1] = t[1]; v[4 * i + 2] = t[2]; v[4 * i + 3] = t[3]; s += t[0] + t[1] + t[2] + t[3]; }
      s += __shfl_xor(s, 1); s += __shfl_xor(s, 2); const float mu = s * (1.f / 128.f);
      float q = 0.f;
#pragma unroll
      for (int i = 0; i < 32; ++i) { v[i] -= mu; q += v[i] * v[i]; }
      q += __shfl_xor(q, 1); q += __shfl_xor(q, 2); const float rstd = rsqrtf(q * (1.f / 128.f) + EPS);
      u16* gp = PJ(proj, tok0 + r, C_RG + h * 128 + q4 * 32);
#pragma unroll
      for (int i = 0; i < 4; ++i) { const u32x4 gv = *(const u32x4*)(gp + i * 8); u32x4 o;
#pragma unroll
          for (int e = 0; e < 4; ++e) o[e] = pk2(v[8 * i + 2 * e] * rstd * siluf(bflo(gv[e])), v[8 * i + 2 * e + 1] * rstd * siluf(bfhi(gv[e])));
          if (!dry) *(u32x4*)(gp + i * 8) = o; } }
}

__device__ __forceinline__ bf16x8 frag_vt_ld(lds_t base, int ld, int e0, int k2, int fr, int fq) {
    lds_t p = base + ((32 * k2 + 4 * fq + (fr >> 2)) * ld + e0 + 4 * (fr & 3)) * 2;
    const s16x4 lo = trrd(p), hi = trrd(p + 16 * ld * 2);
    return (bf16x8){lo[0], lo[1], lo[2], lo[3], hi[0], hi[1], hi[2], hi[3]};
}
__device__ __forceinline__ void ssd_out_item(lds_t lds, u16* proj, const u16* ssdS, const float* dtraw, const float* cw, const float* cb, const float* dt_bias, const float* a_log,
                                             const float* d_skip, const float* norm_g, int it, bool dry) {
    const int tid = otid(), wid = tid >> 6, lane = tid & 63, fr = lane & 15, fq = lane >> 4;
    const int g = it & 1, bc = it >> 1, c = bc & 63, b = bc >> 6;
    const size_t tok0 = (size_t)b * SEQ + c * 128;
    lds_t Cs = lds, Bm = lds + 34816, XS = lds + 69632, acs = lds + 139264, dlt = lds + 141312, acsT = lds + 143360, dltT = lds + 145408, ssq = lds + 147456;
    __syncthreads();
    ssd_dt(acs, dlt, dtraw, dt_bias, a_log, tok0, g);
    { const int t = tid >> 2, hh = tid & 3; *(LAS float*)(acsT + (hh * 128 + t) * 4) = *(const LAS float*)(acs + tid * 4); *(LAS float*)(dltT + (hh * 128 + t) * 4) = *(const LAS float*)(dlt + tid * 4); }
    conv_tile<16, false>(Cs, 136, proj, tok0, c * 128, 768 + g * 128, cw, cb, acs);
    conv_tile<16, false>(Bm, 136, proj, tok0, c * 128, 512 + g * 128, cw, cb, acs);
    conv_tile<32, false>(XS, 272, proj, tok0, c * 128, g * 256, cw, cb, acs);
    __syncthreads();
    const int l = 16 * wid + fr;
    bf16x8 cf[4];
#pragma unroll
    for (int ks = 0; ks < 4; ++ks) cf[ks] = frag_row(Cs, 136, 16 * wid, 32 * ks, fr, fq);
    f32x4 cbT[8];
    { bf16x8 kf[2][8];
#pragma unroll
      for (int u = 0; u < 8; ++u) kf[0][u] = frag_row(Bm, 136, 16 * (u >> 2), 32 * (u & 3), fr, fq);
#pragma unroll
      for (int np = 0; np < 4; ++np) {
          if (np + 1 < 4) {
#pragma unroll
              for (int u = 0; u < 8; ++u) kf[(np + 1) & 1][u] = frag_row(Bm, 136, 16 * (2 * np + 2 + (u >> 2)), 32 * (u & 3), fr, fq); }
          __builtin_amdgcn_sched_barrier(0);
          cbT[2 * np] = (f32x4){0.f, 0.f, 0.f, 0.f}; cbT[2 * np + 1] = (f32x4){0.f, 0.f, 0.f, 0.f};
#pragma unroll
          for (int ks = 0; ks < 4; ++ks) { cbT[2 * np] = MFMA16(kf[np & 1][ks], cf[ks], cbT[2 * np]); cbT[2 * np + 1] = MFMA16(kf[np & 1][4 + ks], cf[ks], cbT[2 * np + 1]); }
          __builtin_amdgcn_sched_barrier(0); } }
    u16* gp = PJ(proj, tok0 + l, C_Z + g * 256 + 4 * fq);
#pragma unroll 1
    for (int hh = 0; hh < 4; ++hh) {
        const int h = 4 * g + hh;
        const u16* pv = ssdS + ((size_t)bc * 8 + h) * 8192 + (size_t)fr * 128 + 8 * fq;
        const float al = *(const LAS float*)(acsT + (hh * 128 + l) * 4);
        bf16x8 pf[16];
#pragma unroll
        for (int u = 0; u < 16; ++u) pf[u] = __builtin_bit_cast(bf16x8, *(const u32x4*)(pv + (size_t)(u >> 2) * 2048 + 32 * (u & 3)));
        bf16x8 bp[4];
#pragma unroll
        for (int k2 = 0; k2 < 4; ++k2) { f32x4 pa[2];
#pragma unroll
            for (int u = 0; u < 2; ++u) { const int n = 2 * k2 + u, s0 = 16 * n + 4 * fq;
                const f32x4 as = *(const LAS f32x4*)(acsT + (hh * 128 + s0) * 4), ds = *(const LAS f32x4*)(dltT + (hh * 128 + s0) * 4);
#pragma unroll
                for (int r = 0; r < 4; ++r) pa[u][r] = (s0 + r <= l) ? cbT[n][r] * __expf(al - as[r]) * ds[r] : 0.f; }
            bp[k2] = pack8(pa[0], pa[1]); }
        f32x4 yd[4], yo[4];
#pragma unroll
        for (int m = 0; m < 4; ++m) { yd[m] = (f32x4){0.f, 0.f, 0.f, 0.f}; yo[m] = (f32x4){0.f, 0.f, 0.f, 0.f}; }
#pragma unroll
        for (int hf = 0; hf < 2; ++hf) { bf16x8 xf[8];
#pragma unroll
            for (int u = 0; u < 8; ++u) xf[u] = frag_vt_ld(XS, 272, hh * 64 + 16 * (2 * hf + (u >> 2)), u & 3, fr, fq);
            __builtin_amdgcn_sched_barrier(0);
#pragma unroll
            for (int k2 = 0; k2 < 4; ++k2) { yd[2 * hf] = MFMA16(xf[k2], bp[k2], yd[2 * hf]); yd[2 * hf + 1] = MFMA16(xf[4 + k2], bp[k2], yd[2 * hf + 1]);
                yo[2 * hf] = MFMA16(pf[8 * hf + k2], cf[k2], yo[2 * hf]); yo[2 * hf + 1] = MFMA16(pf[8 * hf + 4 + k2], cf[k2], yo[2 * hf + 1]); }
            __builtin_amdgcn_sched_barrier(0); }
        const float dsk = d_skip[h], ea = __expf(al);
        float part = 0.f;
#pragma unroll
        for (int m = 0; m < 4; ++m) { const u32x2 xw = *(const LAS u32x2*)(XS + (l * 272 + hh * 64 + 16 * m + 4 * fq) * 2);
            u16* gz = PJ(proj, tok0 + l, C_Z + g * 256 + hh * 64 + 16 * m + 4 * fq);
            const u32x2 zw = *(const u32x2*)(gz);
            const float v0 = (yd[m][0] + ea * yo[m][0] + dsk * bflo(xw[0])) * siluf(bflo(zw[0])), v1 = (yd[m][1] + ea * yo[m][1] + dsk * bfhi(xw[0])) * siluf(bfhi(zw[0]));
            const float v2 = (yd[m][2] + ea * yo[m][2] + dsk * bflo(xw[1])) * siluf(bflo(zw[1])), v3 = (yd[m][3] + ea * yo[m][3] + dsk * bfhi(xw[1])) * siluf(bfhi(zw[1]));
            u32x2 o; o[0] = pk2(v0, v1); o[1] = pk2(v2, v3);
            if (!dry) *(u32x2*)(gz) = o;
            part += v0 * v0 + v1 * v1 + v2 * v2 + v3 * v3; }
        part += __shfl_xor(part, 16); part += __shfl_xor(part, 32);
        if (fq == 0) *(LAS float*)(ssq + (l * 4 + hh) * 4) = part;
    }
    __syncthreads();
    { const int r = tid >> 2, q4 = tid & 3;
      const f32x4 p0 = *(const LAS f32x4*)(ssq + r * 16);
      const float ss = p0[0] + p0[1] + p0[2] + p0[3];
      const float rr = rsqrtf(ss * (1.f / 256.f) + EPS);
      const int gqc = C_Z + g * 256 + q4 * 64;
      const float* ng = norm_g + g * 256 + q4 * 64;
#pragma unroll
      for (int i = 0; i < 8; ++i) { u16* gq = PJ(proj, tok0 + r, gqc + i * 8); const u32x4 zv = *(const u32x4*)(gq); const f32x4 g0 = *(const f32x4*)(ng + i * 8), g1 = *(const f32x4*)(ng + i * 8 + 4); u32x4 o;
          o[0] = pk2(bflo(zv[0]) * rr * g0[0], bfhi(zv[0]) * rr * g0[1]); o[1] = pk2(bflo(zv[1]) * rr * g0[2], bfhi(zv[1]) * rr * g0[3]);
          o[2] = pk2(bflo(zv[2]) * rr * g1[0], bfhi(zv[2]) * rr * g1[1]); o[3] = pk2(bflo(zv[3]) * rr * g1[2], bfhi(zv[3]) * rr * g1[3]);
          if (!dry) *(u32x4*)(gq) = o; } }
}

#define XB_TMO      128
#define XB_XCNT(j)  (256  + 64 * (j))
#define XB_XSUB(j)  (1280 + 64 * (j))
#define XB_XGEN(j)  (2304 + 64 * (j))
#define XB_TOP      3328
#define XB_TOPGEN   3392
#define XCD_BAR_WORDS 3456
#define XB_SPIN_CAP (1u << 18)

__device__ __forceinline__ unsigned xb_ld(unsigned* p)              { return __hip_atomic_load(p, __ATOMIC_RELAXED, __HIP_MEMORY_SCOPE_AGENT); }
__device__ __forceinline__ unsigned xb_add(unsigned* p, unsigned v) { return __hip_atomic_fetch_add(p, v, __ATOMIC_RELAXED, __HIP_MEMORY_SCOPE_AGENT); }
__device__ __forceinline__ unsigned xb_xcc_id() { return (unsigned)__builtin_amdgcn_s_getreg((3 << 11) | 20) & 0xFu; }
#define XB_SPIN(cond, bar) do { unsigned _sp = 0; while (cond) { __builtin_amdgcn_s_sleep(1); \
    if ((++_sp & 255u) == 0u) { if (xb_ld(&(bar)[XB_TMO])) break; if (_sp > XB_SPIN_CAP) { atomicAdd(&(bar)[XB_TMO], 1u); break; } } } } while (0)

struct XcdBarrier {
    unsigned* bar; unsigned x;
    volatile LAS unsigned* st;
};

__device__ __forceinline__ XcdBarrier xcd_barrier_post(unsigned* bar, volatile LAS unsigned* st) {
    XcdBarrier b; b.bar = bar; b.x = xb_xcc_id(); b.st = st;
    if (threadIdx.x == 0) (void)xb_add(&bar[XB_XCNT(b.x)], 1u);
    return b;
}
__device__ __forceinline__ void xcd_barrier_complete(unsigned* bar, unsigned x, unsigned& nloc, unsigned& nx) {
    const unsigned G = gridDim.x * gridDim.y * gridDim.z;
    unsigned sum, cnt, mine, sp = 0u;
    for (;;) {
        sum = 0u; cnt = 0u; mine = 0u;
#pragma unroll
        for (unsigned j = 0; j < 16; ++j) { const unsigned c = xb_ld(&bar[XB_XCNT(j)]); sum += c; cnt += (c > 0u) ? 1u : 0u; mine = (j == x) ? c : mine; }
        if (sum == G) break;
        __builtin_amdgcn_s_sleep(1);
        if ((++sp & 255u) == 0u) { if (xb_ld(&bar[XB_TMO])) break; if (sp > XB_SPIN_CAP) { atomicAdd(&bar[XB_TMO], 1u); break; } }
    }
    nloc = mine > 0u ? mine : 1u; nx = cnt > 0u ? cnt : 1u;
}

__device__ __forceinline__ void xcd_barrier(const XcdBarrier& b) {
    asm volatile("s_waitcnt vmcnt(0)" ::: "memory");
    __syncthreads();
    if (threadIdx.x == 0) {
        unsigned* bar = b.bar;
        __builtin_amdgcn_s_waitcnt(0);
        unsigned nloc = b.st[0], nx = b.st[1];
        if (nloc == 0u) { xcd_barrier_complete(bar, b.x, nloc, nx); b.st[0] = nloc; b.st[1] = nx; }
        const unsigned old = xb_add(&bar[XB_XSUB(b.x)], 1u);
        const unsigned gen = old / nloc;
        if (old + 1u == (gen + 1u) * nloc) {
            __builtin_amdgcn_fence(__ATOMIC_RELEASE, "agent");
            asm volatile("s_waitcnt vmcnt(0)" ::: "memory");
            const unsigned og = xb_add(&bar[XB_TOP], 1u);
            const unsigned tg = og / nx;
            if (og + 1u == (tg + 1u) * nx) xb_add(&bar[XB_TOPGEN], 1u);
            else XB_SPIN(xb_ld(&bar[XB_TOPGEN]) == tg, bar);
            __builtin_amdgcn_fence(__ATOMIC_ACQUIRE, "agent");
            xb_add(&bar[XB_XGEN(b.x)], 1u);
            asm volatile("s_waitcnt vmcnt(0)" ::: "memory");
        } else {
            XB_SPIN(xb_ld(&bar[XB_XGEN(b.x)]) == gen, bar);
            __builtin_amdgcn_fence(__ATOMIC_ACQUIRE, "agent");
            asm volatile("s_waitcnt vmcnt(0)" ::: "memory");
        }
    }
    __syncthreads();
}


__global__ void __launch_bounds__(NTHR, 2) hybrid_fwd(Params p0) {
    extern __shared__ __attribute__((aligned(16))) unsigned char shm_raw[];
    lds_t lds = (lds_t)shm_raw;
    cg::grid_group grid = cg::this_grid();
    volatile LAS unsigned* xst = (volatile LAS unsigned*)(lds + LDS_BYTES - 16);
    if (threadIdx.x == 0) { xst[0] = 0u; xst[1] = 0u; }
    __syncthreads();
    const XcdBarrier xb = xcd_barrier_post((unsigned*)(p0.ws + WS_BAR), xst);
    for (int pi = p0.ph_lo; pi < p0.ph_hi; ++pi) {
        if (pi > p0.ph_lo) { if (p0.ph_lo < 0) grid.sync();
            xcd_barrier(xb); }
        __builtin_amdgcn_s_setprio(0);
        const int ph = p0.prog[pi] & 63; const bool dry = (p0.prog[pi] & 64) != 0; const int im = dry ? p0.dmask : 1023;
        Params p = p0;
        asm volatile("" : "+s"(p.ws), "+s"(p.out));
        u16* proj = (u16*)(p.ws + WS_PROJ);
        u16* retS = (u16*)(p.ws + WS_ST); u16* ssdS = retS + 16777216; u16* yh = retS;
        u16* WinT = (u16*)(p.ws + WS_WIN); u16* WoutT = (u16*)(p.ws + WS_WOUT); u16* memkv = (u16*)(p.ws + WS_MEMKV);
        const float* rc = (const float*)(p.ws + WS_ROPE); const float* rs = rc + SEQ * 64;
        float* dtraw = (float*)(p.ws + WS_DT); float* cdec = (float*)(p.ws + WS_CDEC);
        if (ph == 0) { if (PM & 1) phase_prep(lds, p); continue; }
        const int layer = (ph - 1) / 6, k = (ph - 1) % 6;
        if ((k == 1 || k == 3) && __builtin_amdgcn_readfirstlane(otid()) >= 256) __builtin_amdgcn_s_setprio(1);
        if (k == 0 || k == 4 || (k == 2 && layer == 0 && !dry)) {
            const int njobs = (k == 2) ? 3 : 1;
            for (int j = (k == 2) ? 1 : 0; j < njobs; ++j) {
                pg8::Gemm g; int c = blockIdx.x;
                g.astream = 0; g.ostream = 0;
                if (k == 0) { g.A = yh; g.lda = 1024; g.Bt = WinT; g.ldb = 1024; g.M = T_TOK; g.N = NP; g.K = 1024; g.O = proj; g.ldc = NP; g.ostream = 1; }
                else if (k == 2) { const int l = j - 1; g.A = (const u16*)p.out + (size_t)l * 1048576; g.lda = 1024; g.Bt = (const u16*)p.out + 2097152 + (size_t)l * 1048576; g.ldb = 1024;
                    g.M = 1024; g.N = 1024; g.K = 1024; g.O = memkv + (size_t)l * 1048576; g.ldc = 1024; c = (int)((blockIdx.x + gridDim.x - 16u * l) % gridDim.x); }
                else { g.A = proj + (size_t)(C_RG >> 5) * STRM; g.lda = 32; g.astream = 1; g.Bt = WoutT; g.ldb = 2048; g.M = T_TOK; g.N = 1024; g.K = 2048; g.O = yh; g.ldc = 1024; }
                pg8::StaticOrder S; S.init(g.M, g.N, (int)gridDim.x, c);
                if (PM & 2) pg8::gemm_phase(lds, g, S);
            }
        } else if (k == 1) {
            const float* cw = p.conv_w + (size_t)layer * 4096; const float* cbias = p.conv_b + (size_t)layer * 1024;
            const int G1_ = (int)gridDim.x, b0_ = (int)blockIdx.x;
            for (int pass = 0; pass < 3; ++pass) {
            const int lo_ = pass == 0 ? 0 : (pass == 1 ? 2048 : 1024), hi_ = pass == 0 ? 1024 : (pass == 1 ? 2560 : 2048);
            for (int it = b0_ + ((lo_ - b0_ + G1_ - 1) / G1_) * G1_ * (lo_ > b0_ ? 1 : 0); it < hi_; it += G1_) {
                if (it < lo_) continue;
                if (it < 1024) { if (im & 4) sb_item(lds, proj, (it & ~63) | ((it + 16 * ((it >> 8) & 3)) & 63), dry); }
                else if (it < 2048) { const int i2 = it - 1024; if (im & 16) ret_state_item(lds, proj, retS, rc, rs, (i2 & ~(63 << 2)) | ((((i2 >> 2) + 16 * ((i2 >> 8) & 3)) & 63) << 2)); }
                else { const int i2 = it - 2048; if (im & 32) ssd_state_item(lds, proj, ssdS, cdec, dtraw, cw, cbias, p.dt_bias + layer * 8, p.a_log + layer * 8, (i2 & ~(63 << 1)) | ((((i2 >> 1) + 16 * ((i2 >> 8) & 1)) & 63) << 1)); }
            }
            }
        }
        if (k == 2) {
            if ((PM & 64) && !dry) scan_phase(retS, ssdS, cdec, dry);
        } else if (k == 3) {
            const float* cw = p.conv_w + (size_t)layer * 4096; const float* cbias = p.conv_b + (size_t)layer * 1024;
            for (int it = blockIdx.x; it < 1536; it += gridDim.x) {
                if (it < 1024) { if (im & 128) ret_out_item(lds, proj, retS, rc, rs, (it & ~(63 << 2)) | ((((it >> 2) + 16 * ((it >> 8) & 3)) & 63) << 2), dry); }
                else { if (im & 256) ssd_out_item(lds, proj, ssdS, dtraw, cw, cbias, p.dt_bias + layer * 8, p.a_log + layer * 8, p.d_skip + layer * 8, p.ssd_norm_g + layer * 512, ((it - 1024) & ~(63 << 1)) | (((((it - 1024) >> 1) + 16 * (((it - 1024) >> 8) & 1)) & 63) << 1), dry); }
            }
            if (im & 8) mem_group(lds, proj, memkv + (size_t)layer * 1048576, dry);
        } else if (k == 5) {
            const bool has_next = layer == 0;
            if (has_next) { convert_win(lds, p.w_in + (size_t)1024 * DIN, WinT); convert_wout(lds, p.w_out + (size_t)2048 * 1024, WoutT); }
            if (PM & 512) row_pass(lds, layer == 0 ? p.x : p.out, p.out, yh, true, p.post_g + layer * 1024, has_next, p.pre_g + 1024, p.w_in + (size_t)1024 * DIN, dtraw, dry);
        }
    }
}


#ifdef DBG_STOP
__global__ void dbg_dump(Params p) {
    const u16* proj = (const u16*)(p.ws + WS_PROJ); const u16* st = (const u16*)(p.ws + WS_ST);
    const u16* mk = (const u16*)(p.ws + WS_MEMKV); const float* dt = (const float*)(p.ws + WS_DT); const float* cd = (const float*)(p.ws + WS_CDEC);
    const float* rp = (const float*)(p.ws + WS_ROPE);
    for (size_t i = (size_t)blockIdx.x * blockDim.x + threadIdx.x; i < (size_t)T_TOK * DM; i += (size_t)gridDim.x * blockDim.x) {
        float a = 0.f;
#if DBG_WHAT & 1
        for (int j = 0; j < 6; ++j) a += bf2f(proj[i * 6 + j]);
        a += bf2f(proj[201326592ull + (i >> 1)]);
#endif
#if DBG_WHAT & 2
        a += bf2f(st[i]);
#endif
#if DBG_WHAT & 4
        a += bf2f(mk[i & 2097151]) + dt[i & 262143] + cd[i & 2047] + rp[i & 1048575];
#endif
        p.out[i] = a;
    }
}
#endif

#ifdef DBG_STOP
constexpr int N_PHASES = DBG_STOP;
#else
constexpr int N_PHASES = 13;
#endif

extern "C" void kernel_launch(void* const* d_in, const int* in_sizes, int n_in, void* d_out, int out_size, void* d_ws, size_t ws_size, hipStream_t stream) {
    static int grid = 0;
    if (grid == 0) {
        if (n_in != 14 || in_sizes[0] != T_TOK * DM || out_size != T_TOK * DM || ws_size < WS_END) {
            fprintf(stderr, "kernel_launch: unexpected shapes (n_in %d, in0 %d, out %d, ws %zu need %zu)\n", n_in, n_in > 0 ? in_sizes[0] : -1, out_size, ws_size, (size_t)WS_END); grid = -1; return; }
        int dev = 0, cus = 0, per_cu = 0;
        hipGetDevice(&dev); hipDeviceGetAttribute(&cus, hipDeviceAttributeMultiprocessorCount, dev);
        if (hipFuncSetAttribute((const void*)hybrid_fwd, hipFuncAttributeMaxDynamicSharedMemorySize, LDS_BYTES) != hipSuccess) { fprintf(stderr, "kernel_launch: hipFuncSetAttribute failed\n"); grid = -1; return; }
        if (hipOccupancyMaxActiveBlocksPerMultiprocessor(&per_cu, (const void*)hybrid_fwd, NTHR, LDS_BYTES) != hipSuccess || per_cu < 1) per_cu = 1;
        (void)hipGetLastError();
        grid = cus * 1;
    }
    if (grid < 0) return;
    if (hipMemsetAsync((char*)d_ws + WS_BAR, 0, 16384, stream) != hipSuccess) { fprintf(stderr, "kernel_launch: memset failed\n"); return; }
    Params p{};
    p.x = (const float*)d_in[0]; p.mem = (const float*)d_in[1]; p.pre_g = (const float*)d_in[2]; p.post_g = (const float*)d_in[3]; p.w_in = (const float*)d_in[4];
    p.conv_w = (const float*)d_in[5]; p.conv_b = (const float*)d_in[6]; p.dt_bias = (const float*)d_in[7]; p.a_log = (const float*)d_in[8]; p.d_skip = (const float*)d_in[9];
    p.ssd_norm_g = (const float*)d_in[10]; p.mem_norm_g = (const float*)d_in[11]; p.w_mem_kv = (const float*)d_in[12]; p.w_out = (const float*)d_in[13];
    p.out = (float*)d_out; p.ws = (unsigned char*)d_ws;
    int np = 0;
#ifdef DMASK
    p.dmask = DMASK;
#else
    p.dmask = 1023;
#endif
    for (int ph = 0; ph < N_PHASES; ++ph) { p.prog[np++] = (unsigned char)ph;
#ifdef DUP_PHASE
        if (ph == DUP_PHASE) for (int d = 0; d < DUP_TIMES; ++d) p.prog[np++] = (unsigned char)(ph | 64);
#endif
    }
#if N_LAUNCH_MODE == 1
    p.ph_lo = 0; p.ph_hi = np;
    void* args[] = {&p};
    hipError_t e = hipLaunchCooperativeKernel((const void*)hybrid_fwd, dim3(grid), dim3(NTHR), args, LDS_BYTES, stream);
    if (e != hipSuccess) fprintf(stderr, "cooperative launch failed: %s (grid %d)\n", hipGetErrorString(e), grid);
#else
    for (int ph = 0; ph < np; ++ph) { p.ph_lo = ph; p.ph_hi = ph + 1; hipLaunchKernelGGL(hybrid_fwd, dim3(grid), dim3(NTHR), LDS_BYTES, stream, p); }
#ifdef DBG_STOP
    p.ph_lo = 0; p.ph_hi = 0; hipLaunchKernelGGL(dbg_dump, dim3(2048), dim3(256), 0, stream, p);
#endif
#endif
}
```
